# Optimizing an MI355X kernel written in HIP

```python
import jax
import jax.numpy as jnp
from jax import lax
import numpy as np

D_MODEL = 2048
BATCH = 4
SEQ = 2048
DEPTH = 2
DEC_BATCH = 128
DEC_SEQ = 4
PAST_LEN = 16384
PAGE_SIZE = 128

N_GROUPS = 4
GROUP_W = D_MODEL // N_GROUPS
RWKV_HEAD = 64
RWKV_HEADS = GROUP_W // RWKV_HEAD
W_LORA = 32
A_LORA = 32
G_LORA = 96
RWKV_GN_EPS = 64e-5
SGU_CHUNK = 128
SGU_HEADS = 4
SGU_HEAD = GROUP_W // SGU_HEADS
HGRN_HEADS = 4
HGRN_HEAD = GROUP_W // HGRN_HEADS
HGRN_CHUNK = 64
POOL_WINDOWS = (2, 4, 8, 16)
POOL_GROUPS = len(POOL_WINDOWS)
POOL_CH = GROUP_W // POOL_GROUPS
POOL_HIST = max(POOL_WINDOWS) - 1
D_FF = -(-8 * D_MODEL // (3 * 256)) * 256
PLE_DIM = 256
NORM_EPS = 1e-6
LN_EPS = 1e-5
RWKV_COLS = 3 * GROUP_W + W_LORA + A_LORA + G_LORA
SGU_COLS = 2 * GROUP_W
HGRN_COLS = 4 * GROUP_W
POOL_COLS = GROUP_W
IN_COLS = RWKV_COLS + SGU_COLS + HGRN_COLS + POOL_COLS

kernel_name = "hybrid_rwkv7_sgu_hgrn2_pool_decode_step"

F32 = jnp.float32


def _rmsnorm(x, g):
    xf = x.astype(F32)
    return xf * lax.rsqrt(jnp.mean(xf * xf, axis=-1, keepdims=True) + NORM_EPS) * g.astype(F32)


def _rwkv7(z, shift_prev, wkv0, w):
    B, L, _ = z.shape
    G = GROUP_W
    z_prev = jnp.concatenate([shift_prev[:, None, :].astype(F32), z[:, :-1]], axis=1)
    zm = z + w['rwkv_mu'] * (z_prev - z)
    r, k, v, xw, xa, xg = jnp.split(zm, [G, 2 * G, 3 * G, 3 * G + W_LORA, 3 * G + W_LORA + A_LORA], axis=-1)
    w_log = -jax.nn.softplus(-(w['rwkv_w0'] + jnp.tanh(xw) @ w['rwkv_w_lora'])) - 0.5
    decay = jnp.exp(-jnp.exp(w_log))
    a = jax.nn.sigmoid(w['rwkv_a0'] + xa @ w['rwkv_a_lora'])
    g = jax.nn.sigmoid(xg) @ w['rwkv_g_lora']
    hs = lambda t: t.reshape(B, L, RWKV_HEADS, RWKV_HEAD)
    kk = hs(k * w['rwkv_k_k'])
    kk = kk / jnp.maximum(jnp.linalg.norm(kk, axis=-1, keepdims=True), 1e-12)
    k = k * (1.0 + (a - 1.0) * w['rwkv_k_a'])
    r, k, v, decay, a = hs(r), hs(k), hs(v), hs(decay), hs(a)
    a_vec = -kk
    b_vec = kk * a

    def step(S, inp):
        r_t, w_t, k_t, v_t, av_t, bv_t = inp
        sa = jnp.einsum('bhvk,bhk->bhv', S, av_t)
        S = (S * w_t[:, :, None, :] + sa[..., None] * bv_t[:, :, None, :]
             + v_t[..., None] * k_t[:, :, None, :])
        return S, jnp.einsum('bhvk,bhk->bhv', S, r_t)

    xs = tuple(jnp.moveaxis(t, 1, 0) for t in (r, decay, k, v, a_vec, b_vec))
    S_fin, ys = lax.scan(step, wkv0.astype(F32), xs)
    y = jnp.moveaxis(ys, 0, 1)
    mean = jnp.mean(y, axis=-1, keepdims=True)
    var = jnp.mean(jnp.square(y - mean), axis=-1, keepdims=True)
    yn = ((y - mean) * lax.rsqrt(var + RWKV_GN_EPS)).reshape(B, L, G) * w['rwkv_gn_w'] + w['rwkv_gn_b']
    bonus = (jnp.sum(r * k * w['rwkv_r_k'], axis=-1, keepdims=True) * v).reshape(B, L, G)
    return (yn + bonus) * g, S_fin, z[:, -1]


def _sgu(z, w):
    B, L, _ = z.shape
    z = jax.nn.gelu(z, approximate=False)
    u, v = jnp.split(z, 2, axis=-1)
    mu = jnp.mean(v, axis=-1, keepdims=True)
    var = jnp.mean(jnp.square(v - mu), axis=-1, keepdims=True)
    v = (v - mu) * lax.rsqrt(var + LN_EPS) * w['sgu_ln_w'] + w['sgu_ln_b']
    n = -(-L // SGU_CHUNK)
    vp = jnp.pad(v, ((0, 0), (0, n * SGU_CHUNK - L), (0, 0))).reshape(B, n, SGU_CHUNK, SGU_HEADS, SGU_HEAD)
    mask = jnp.tril(jnp.ones((SGU_CHUNK, SGU_CHUNK), dtype=bool))
    wm = jnp.where(mask[None], w['sgu_w'], 0.0)
    s = jnp.einsum('hts,bnshd->bnthd', wm, vp) + w['sgu_b'].T[None, None, :, :, None]
    s = s.reshape(B, n * SGU_CHUNK, GROUP_W)[:, :L]
    return _rmsnorm(u * s, w['sgu_norm']), v


def _hgrn2_chunked(q, k, v, logf, S0):
    B, H, L, _ = q.shape
    C = min(HGRN_CHUNK, L)
    n = -(-L // C)
    pad = n * C - L

    def blocks(t):
        t = jnp.pad(t, ((0, 0), (0, 0), (0, pad), (0, 0)))
        return jnp.moveaxis(t.reshape(B, H, n, C, t.shape[-1]), 2, 0)

    mask = jnp.tril(jnp.ones((C, C), dtype=bool))[:, :, None]

    def step(S, inp):
        qc, kc, vc, gc = inp
        b = jnp.cumsum(gc, axis=2)
        diff = b[:, :, :, None, :] - b[:, :, None, :, :]
        dec = jnp.exp(jnp.where(mask, diff, -jnp.inf))
        att = jnp.einsum('bhtsd,bhsd->bhts', qc[:, :, :, None, :] * dec, kc)
        o = (jnp.einsum('bhts,bhsv->bhtv', att, vc)
             + jnp.einsum('bhtd,bhdv->bhtv', qc * jnp.exp(b), S))
        b_last = b[:, :, -1:, :]
        S = (jnp.exp(b_last[:, :, 0, :])[..., None] * S
             + jnp.einsum('bhsd,bhsv->bhdv', kc * jnp.exp(b_last - b), vc))
        return S, o

    S, o = lax.scan(step, S0, (blocks(q), blocks(k), blocks(v), blocks(logf)))
    o = jnp.moveaxis(o, 0, 2).reshape(B, H, n * C, -1)[:, :, :L]
    return o, S


def _hgrn2(z, S0, lb, w):
    B, L, _ = z.shape
    q, f, i_in, g = jnp.split(z, 4, axis=-1)
    q = jax.nn.silu(q)
    fg = lb + (1.0 - lb) * jax.nn.sigmoid(f)
    logf = jnp.log(fg)
    k = 1.0 - fg
    th = lambda t: t.reshape(B, L, HGRN_HEADS, HGRN_HEAD).transpose(0, 2, 1, 3)
    o, S = _hgrn2_chunked(th(q), th(k), th(i_in), th(logf), S0.astype(F32))
    o = o.transpose(0, 2, 1, 3)
    o = o * lax.rsqrt(jnp.mean(o * o, axis=-1, keepdims=True) + NORM_EPS)
    return o.reshape(B, L, GROUP_W) * w['hgrn_norm'] * jax.nn.silu(g), S


def _pool(z, hist, start_pos, w):
    B, L, _ = z.shape
    full = jnp.concatenate([hist.astype(F32), z], axis=1)
    cs = jnp.pad(jnp.cumsum(full, axis=1), ((0, 0), (1, 0), (0, 0)))
    pos = start_pos + jnp.arange(L)
    outs = []
    for gi, win in enumerate(POOL_WINDOWS):
        sl = slice(gi * POOL_CH, (gi + 1) * POOL_CH)
        hi = cs[:, POOL_HIST + 1:POOL_HIST + 1 + L, sl]
        lo = cs[:, POOL_HIST + 1 - win:POOL_HIST + 1 - win + L, sl]
        cnt = jnp.minimum(pos + 1, win).astype(F32)
        outs.append((hi - lo) / cnt[None, :, None])
    d = (jnp.concatenate(outs, axis=-1) - z).reshape(B, L, POOL_GROUPS, POOL_CH)
    y = jnp.einsum('blgc,gcd->blgd', d, w['pool_w']).reshape(B, L, GROUP_W) * w['pool_scale']
    return y, full[:, -POOL_HIST:]


def _trunk(x, p, wkv0, shift0, hgrn0, pool0, start_pos, W, lb_all):
    dtype = x.dtype
    wkv_l, shift_l, hgrn_l, pool_l, sgu_l = [], [], [], [], []
    c1, c2, c3 = RWKV_COLS, RWKV_COLS + SGU_COLS, RWKV_COLS + SGU_COLS + HGRN_COLS
    for i in range(DEPTH):
        w = {name: arr[i] for name, arr in W.items()}
        h = _rmsnorm(x, w['ln_mix_pre'])
        z = jnp.einsum('bld,dc->blc', h, w['w_in']).astype(F32)
        z_r, z_s, z_h, z_p = jnp.split(z, [c1, c2, c3], axis=-1)
        y_r, wkv_new, shift_new = _rwkv7(z_r, shift0[i], wkv0[i], w)
        y_s, v_rows = _sgu(z_s, w)
        y_h, hgrn_new = _hgrn2(z_h, hgrn0[i], lb_all[i], w)
        y_p, pool_new = _pool(z_p, pool0[i], start_pos, w)
        mix = jnp.einsum('blc,cd->bld', jnp.concatenate([y_r, y_s, y_h, y_p], axis=-1), w['w_out'])
        xf = x.astype(F32) + _rmsnorm(mix, w['ln_mix_post'])
        h2 = _rmsnorm(xf, w['ln_ffn_pre'])
        gate, up = jnp.split(jnp.einsum('bld,df->blf', h2, w['ffn_w_gu']), 2, axis=-1)
        ff = jnp.einsum('blf,fd->bld', jax.nn.silu(gate) * up, w['ffn_w_down'])
        xf = xf + _rmsnorm(ff, w['ln_ffn_post'])
        ple = jnp.einsum('ble,ed->bld', p[i].astype(F32), w['ple_proj'])
        xf = xf + jax.nn.sigmoid(jnp.einsum('bld,de->ble', xf, w['ple_gate'])) * ple
        x = xf.astype(dtype)
        wkv_l.append(wkv_new)
        shift_l.append(shift_new)
        hgrn_l.append(hgrn_new)
        pool_l.append(pool_new)
        sgu_l.append(v_rows)
    return (x, jnp.stack(wkv_l).astype(dtype), jnp.stack(shift_l).astype(dtype),
            jnp.stack(hgrn_l).astype(dtype), jnp.stack(pool_l).astype(dtype),
            jnp.stack(sgu_l).astype(dtype))


def setup_inputs(seed: int = 0) -> dict:
    key = jax.random.key(seed)
    ks = iter(jax.random.split(key, 64))
    nrm = lambda shape, scale: scale * jax.random.normal(next(ks), shape, F32)
    gain = lambda shape: 1.0 + 0.1 * jax.random.normal(next(ks), shape, F32)
    Dp = DEPTH
    return {
        'x_prompt': nrm((BATCH, SEQ, D_MODEL), 1.0),
        'x_sample': nrm((DEC_BATCH, DEC_SEQ, D_MODEL), 1.0),
        'state_rwkv_wkv': nrm((Dp, DEC_BATCH, RWKV_HEADS, RWKV_HEAD, RWKV_HEAD), 0.3),
        'state_rwkv_shift': nrm((Dp, DEC_BATCH, RWKV_COLS), 1.0),
        'state_hgrn': nrm((Dp, DEC_BATCH, HGRN_HEADS, HGRN_HEAD, HGRN_HEAD), 0.5),
        'state_pool': nrm((Dp, DEC_BATCH, POOL_HIST, GROUP_W), 1.0),
        'p_prompt': nrm((Dp, BATCH, SEQ, PLE_DIM), 1.0),
        'p_sample': nrm((Dp, DEC_BATCH, DEC_SEQ, PLE_DIM), 1.0),
        'ln_mix_pre': gain((Dp, D_MODEL)),
        'ln_mix_post': gain((Dp, D_MODEL)),
        'ln_ffn_pre': gain((Dp, D_MODEL)),
        'ln_ffn_post': gain((Dp, D_MODEL)),
        'w_in': nrm((Dp, D_MODEL, IN_COLS), D_MODEL ** -0.5),
        'rwkv_mu': jax.random.uniform(next(ks), (Dp, RWKV_COLS), F32),
        'rwkv_w_lora': nrm((Dp, W_LORA, GROUP_W), W_LORA ** -0.5),
        'rwkv_w0': nrm((Dp, GROUP_W), 0.5),
        'rwkv_a_lora': nrm((Dp, A_LORA, GROUP_W), A_LORA ** -0.5),
        'rwkv_a0': nrm((Dp, GROUP_W), 0.1),
        'rwkv_g_lora': nrm((Dp, G_LORA, GROUP_W), G_LORA ** -0.5),
        'rwkv_k_k': gain((Dp, GROUP_W)),
        'rwkv_k_a': gain((Dp, GROUP_W)),
        'rwkv_r_k': nrm((Dp, RWKV_HEADS, RWKV_HEAD), 0.1),
        'rwkv_gn_w': gain((Dp, GROUP_W)),
        'rwkv_gn_b': nrm((Dp, GROUP_W), 0.01),
        'sgu_ln_w': gain((Dp, GROUP_W)),
        'sgu_ln_b': nrm((Dp, GROUP_W), 0.02),
        'sgu_w': nrm((Dp, SGU_HEADS, SGU_CHUNK, SGU_CHUNK), SGU_CHUNK ** -0.5),
        'sgu_b': gain((Dp, SGU_HEADS, SGU_CHUNK)),
        'sgu_norm': gain((Dp, GROUP_W)),
        'hgrn_lb_logits': nrm((Dp, GROUP_W), 0.5),
        'hgrn_norm': gain((Dp, GROUP_W)),
        'pool_w': nrm((Dp, POOL_GROUPS, POOL_CH, POOL_CH), POOL_CH ** -0.5),
        'pool_scale': gain((Dp, GROUP_W)),
        'w_out': nrm((Dp, D_MODEL, D_MODEL), D_MODEL ** -0.5),
        'ffn_w_gu': nrm((Dp, D_MODEL, 2 * D_FF), D_MODEL ** -0.5),
        'ffn_w_down': nrm((Dp, D_FF, D_MODEL), D_FF ** -0.5),
        'ple_gate': nrm((Dp, D_MODEL, D_MODEL), D_MODEL ** -0.5),
        'ple_proj': nrm((Dp, PLE_DIM, D_MODEL), PLE_DIM ** -0.5),
    }


def reference(x_prompt, x_sample, state_rwkv_wkv, state_rwkv_shift, state_hgrn, state_pool,
              p_prompt, p_sample, ln_mix_pre, ln_mix_post, ln_ffn_pre, ln_ffn_post, w_in,
              rwkv_mu, rwkv_w_lora, rwkv_w0, rwkv_a_lora, rwkv_a0, rwkv_g_lora, rwkv_k_k,
              rwkv_k_a, rwkv_r_k, rwkv_gn_w, rwkv_gn_b, sgu_ln_w, sgu_ln_b, sgu_w, sgu_b,
              sgu_norm, hgrn_lb_logits, hgrn_norm, pool_w, pool_scale, w_out, ffn_w_gu,
              ffn_w_down, ple_gate, ple_proj):
    W = dict(ln_mix_pre=ln_mix_pre, ln_mix_post=ln_mix_post, ln_ffn_pre=ln_ffn_pre,
             ln_ffn_post=ln_ffn_post, w_in=w_in, rwkv_mu=rwkv_mu, rwkv_w_lora=rwkv_w_lora,
             rwkv_w0=rwkv_w0, rwkv_a_lora=rwkv_a_lora, rwkv_a0=rwkv_a0, rwkv_g_lora=rwkv_g_lora,
             rwkv_k_k=rwkv_k_k, rwkv_k_a=rwkv_k_a, rwkv_r_k=rwkv_r_k, rwkv_gn_w=rwkv_gn_w,
             rwkv_gn_b=rwkv_gn_b, sgu_ln_w=sgu_ln_w, sgu_ln_b=sgu_ln_b, sgu_w=sgu_w, sgu_b=sgu_b,
             sgu_norm=sgu_norm, hgrn_norm=hgrn_norm, pool_w=pool_w, pool_scale=pool_scale,
             w_out=w_out, ffn_w_gu=ffn_w_gu, ffn_w_down=ffn_w_down, ple_gate=ple_gate,
             ple_proj=ple_proj)
    lb_soft = jax.nn.softmax(hgrn_lb_logits.astype(F32), axis=0)
    lb_all = jnp.cumsum(lb_soft, axis=0) - lb_soft[0:1]
    zeros_wkv = jnp.zeros((DEPTH, BATCH, RWKV_HEADS, RWKV_HEAD, RWKV_HEAD), F32)
    zeros_shift = jnp.zeros((DEPTH, BATCH, RWKV_COLS), F32)
    zeros_hgrn = jnp.zeros((DEPTH, BATCH, HGRN_HEADS, HGRN_HEAD, HGRN_HEAD), F32)
    zeros_pool = jnp.zeros((DEPTH, BATCH, POOL_HIST, GROUP_W), F32)
    y_prompt, wkv_p, shift_p, hgrn_p, pool_p, _ = _trunk(
        x_prompt, p_prompt, zeros_wkv, zeros_shift, zeros_hgrn, zeros_pool, 0, W, lb_all)
    y_sample, wkv_s, shift_s, hgrn_s, pool_s, sgu_v_s = _trunk(
        x_sample, p_sample, state_rwkv_wkv, state_rwkv_shift, state_hgrn, state_pool,
        PAST_LEN, W, lb_all)
    return (y_prompt, y_sample, wkv_p, shift_p, hgrn_p, pool_p, wkv_s, shift_s, hgrn_s, pool_s, sgu_v_s)
```

```cpp
#include <hip/hip_runtime.h>
#include <hip/hip_cooperative_groups.h>
#include <cstdio>
#include <cstdint>
namespace cg = cooperative_groups;
__device__ __forceinline__ int ltid() { int t = threadIdx.x; asm volatile("" : "+v"(t)); return t; }
namespace pg8 {
#define PG8_LAS __attribute__((address_space(3)))
typedef unsigned short bf16_t;
typedef short bf16x8 __attribute__((ext_vector_type(8)));
typedef float f32x4 __attribute__((ext_vector_type(4)));
typedef unsigned u32x4 __attribute__((ext_vector_type(4)));
constexpr int BM = 256, BK = 64, HALF = 128, HTB = HALF * BK * 2  , STAGE_BYTES = 8 * HTB, NXCD = 8, WGM = 8;

__host__ __device__ __forceinline__ int lds_byte(int r, int c) { const int st = (r >> 4) * 2 + (c >> 5), rr = r & 15, cc = c & 31, ob = rr * 64 + cc * 2; return st * 1024 + (ob ^ (((ob >> 9) & 1) << 5)); }
__host__ __device__ __forceinline__ void stage_rc(int b, int& R, int& C) { const int st = b / 1024, sb = b % 1024, swz = sb ^ (((sb >> 9) & 1) << 5); R = (st >> 1) * 16 + swz / 64; C = (st & 1) * 32 + (swz % 64) / 2; }
__host__ __device__ __forceinline__ int perm32(int rho) { const int n = rho >> 4, i = rho & 15; return 8 * (i >> 2) + 4 * n + (i & 3); }

struct Unit { int pm, pn; };
struct Gemm { const bf16_t* A; const bf16_t* Bt; int M, N, K; };

struct StaticOrder {
    int nM, nN, nwg, G, c;
    __host__ __device__ void init(int M, int N, int G_, int c_) { nM = M / BM; nN = N / BM; nwg = nM * nN; G = G_; c = c_; }
    __host__ __device__ bool next(int i, Unit& u) const {
        const long L = (long)i * G + c; if (L >= nwg) return false;
        int wgid = (int)L; { const int q = nwg / NXCD, r = nwg % NXCD, xcd = wgid % NXCD, off = wgid / NXCD; wgid = (xcd < r ? xcd * (q + 1) : r * (q + 1) + (xcd - r) * q) + off; }
        const int nig = WGM * nN, gid = wgid / nig, fm = gid * WGM, gsz = (nM - fm) < WGM ? (nM - fm) : WGM;
        u.pm = fm + ((wgid % nig) % gsz); u.pn = (wgid % nig) / gsz; return true;
    }
    __device__ __forceinline__ void a_ready(const Unit&) const {}
    __device__ __forceinline__ void done(const Unit&) const {}
};

__device__ __forceinline__ unsigned cvt_pk_bf16(float lo, float hi) { unsigned r; asm volatile("v_cvt_pk_bf16_f32 %0, %1, %2" : "=v"(r) : "v"(lo), "v"(hi)); return r; }
struct EpiF32 {
    static constexpr bool PERM = false, AFTER_DRAIN = false;
    float* O; int ldc;
    __device__ __forceinline__ void operator()(const f32x4 (&acc)[2][2][4][2], const Unit& u, int wr, int wc, int fr, int fq) const {
#pragma unroll
        for (int ai = 0; ai < 2; ++ai)
#pragma unroll
            for (int m = 0; m < 4; ++m) { float* rowp = O + (size_t)(u.pm * BM + ai * HALF + wr * 64 + m * 16 + fr) * ldc + u.pn * BM + wc * 32 + 4 * fq;
#pragma unroll
                for (int bj = 0; bj < 2; ++bj)
#pragma unroll
                    for (int n = 0; n < 2; ++n) *(f32x4*)(rowp + bj * HALF + n * 16) = acc[ai][bj][m][n]; }
    }
};
struct EpiSwiglu {
    static constexpr bool PERM = false, AFTER_DRAIN = false;
    bf16_t* O; int ldc;
    __device__ __forceinline__ void operator()(const f32x4 (&acc)[2][2][4][2], const Unit& u, int wr, int wc, int fr, int fq) const {
        typedef unsigned u32x2 __attribute__((ext_vector_type(2)));
#pragma unroll
        for (int ai = 0; ai < 2; ++ai)
#pragma unroll
            for (int m = 0; m < 4; ++m) { bf16_t* rowp = O + (size_t)(u.pm * BM + ai * HALF + wr * 64 + m * 16 + fr) * ldc + u.pn * HALF + wc * 32 + 4 * fq;
#pragma unroll
                for (int n = 0; n < 2; ++n) { const f32x4 g = acc[ai][0][m][n], up = acc[ai][1][m][n]; float h[4];
#pragma unroll
                    for (int j = 0; j < 4; ++j) h[j] = g[j] / (1.0f + __expf(-g[j])) * up[j];
                    u32x2 w; w.x = cvt_pk_bf16(h[0], h[1]); w.y = cvt_pk_bf16(h[2], h[3]); *(u32x2*)(rowp + n * 16) = w; } }
    }
};
struct EpiGate {
    static constexpr bool PERM = false, AFTER_DRAIN = false;
    const float* XF; const float* PL; float* O; int ldc;
    __device__ __forceinline__ void operator()(const f32x4 (&acc)[2][2][4][2], const Unit& u, int wr, int wc, int fr, int fq) const {
#pragma unroll
        for (int ai = 0; ai < 2; ++ai)
#pragma unroll
            for (int m = 0; m < 4; ++m) { const size_t off = (size_t)(u.pm * BM + ai * HALF + wr * 64 + m * 16 + fr) * ldc + u.pn * BM + wc * 32 + 4 * fq;
#pragma unroll
                for (int bj = 0; bj < 2; ++bj)
#pragma unroll
                    for (int n = 0; n < 2; ++n) { const size_t o2 = off + bj * HALF + n * 16; const f32x4 a = acc[ai][bj][m][n], xf = *(const f32x4*)(XF + o2), pl = *(const f32x4*)(PL + o2); f32x4 o;
#pragma unroll
                        for (int j = 0; j < 4; ++j) o[j] = xf[j] + pl[j] / (1.0f + __expf(-a[j]));
                        *(f32x4*)(O + o2) = o; } }
    }
};
template <class Epi, class Sched, bool ALIGN_EPI = false, bool SP2 = false>
__device__ __forceinline__ void gemm_phase(PG8_LAS unsigned char* lds, const Gemm g, const Sched& S, const Epi& E) {
    const int tid = ltid(), wid = __builtin_amdgcn_readfirstlane(tid >> 6), lane = tid & 63, wr = wid >> 2, wc = wid & 3, fr = lane & 15, fq = lane >> 4;
    const int K = g.K, nt = K / BK;
    unsigned voffA[2], voffB[2];
#pragma unroll
    for (int i = 0; i < 2; ++i) { int R, C; stage_rc(tid * 16 + i * 8192, R, C); const int Rb = Epi::PERM ? ((R & ~31) + perm32(R & 31)) : R;
        voffA[i] = (unsigned)(R * K + C) * 2u; voffB[i] = (unsigned)(Rb * K + C) * 2u; }
    const size_t kstep = (size_t)(BK * 2);
    const size_t hstep = (size_t)HALF * K * 2;
    const size_t tstep = 2 * hstep;
    const unsigned ldsw = (unsigned)wid * 1024u;
    const int aoff = lds_byte(wr * 64 + fr, fq * 8), boff = lds_byte(wc * 32 + fr, fq * 8);
#define PG8_SA(b, h) (((b) * 2 + (h)) * HTB)
#define PG8_SB(b, h) ((4 + (b) * 2 + (h)) * HTB)
#define PG8_STAGE(bufoff, gbase, voff) do { _Pragma("unroll") for (int _i = 0; _i < 2; ++_i) \
        __builtin_amdgcn_global_load_lds((const unsigned*)((const char*)(gbase) + (voff)[_i]), (PG8_LAS unsigned*)(lds + (bufoff) + ldsw + _i * 8192), 16, 0, 0); } while (0)
#define PG8_LDA(dst, b, h) do { _Pragma("unroll") for (int m = 0; m < 4; ++m) _Pragma("unroll") for (int k = 0; k < 2; ++k) dst[m][k] = *(const PG8_LAS bf16x8*)(lds + PG8_SA(b, h) + aoff + m * 2048 + k * 1024); } while (0)
#define PG8_LDB(dst, b, h) do { _Pragma("unroll") for (int n = 0; n < 2; ++n) _Pragma("unroll") for (int k = 0; k < 2; ++k) dst[n][k] = *(const PG8_LAS bf16x8*)(lds + PG8_SB(b, h) + boff + n * 2048 + k * 1024); } while (0)
#define PG8_MMA(ai, bj, At, Bt) do { __builtin_amdgcn_s_setprio(1); _Pragma("unroll") for (int m = 0; m < 4; ++m) _Pragma("unroll") for (int n = 0; n < 2; ++n) _Pragma("unroll") for (int k = 0; k < 2; ++k) \
        acc[ai][bj][m][n] = __builtin_amdgcn_mfma_f32_16x16x32_bf16(Bt[n][k], At[m][k], acc[ai][bj][m][n], 0, 0, 0); __builtin_amdgcn_s_setprio(0); } while (0)
#define PG8_WAIT_V(n) asm volatile("s_waitcnt vmcnt(" #n ")" ::: "memory")
#define PG8_WAIT_L(n) asm volatile("s_waitcnt lgkmcnt(" #n ")" ::: "memory")
#define PG8_BAR __builtin_amdgcn_s_barrier()
#define PG8_SCHED __builtin_amdgcn_sched_barrier(0)
    Unit cur, nxt; int ui = 0;
    if (!S.next(0, cur)) return;
    f32x4 acc[2][2][4][2];
#pragma unroll
    for (int a = 0; a < 2; ++a)
#pragma unroll
        for (int b = 0; b < 2; ++b)
#pragma unroll
            for (int m = 0; m < 4; ++m)
#pragma unroll
                for (int n = 0; n < 2; ++n) acc[a][b][m][n] = (f32x4){0.f, 0.f, 0.f, 0.f};
    bf16x8 At[4][2], B0[2][2], B1[2][2];
    const char* cA = (const char*)g.A + (size_t)cur.pm * tstep; const char* cB = (const char*)g.Bt + (size_t)cur.pn * tstep;
    S.a_ready(cur);
    if constexpr (SP2) {
        PG8_STAGE(PG8_SB(0, 0), cB, voffB); PG8_STAGE(PG8_SB(0, 1), cB + hstep, voffB); PG8_STAGE(PG8_SA(0, 0), cA, voffA); PG8_STAGE(PG8_SA(0, 1), cA + hstep, voffA);
        if (wr == 1) PG8_BAR;
        PG8_WAIT_V(2); PG8_BAR;
        PG8_STAGE(PG8_SB(1, 0), cB + kstep, voffB); PG8_STAGE(PG8_SA(1, 0), cA + kstep, voffA); PG8_STAGE(PG8_SB(1, 1), cB + hstep + kstep, voffB);
        PG8_WAIT_V(6); PG8_BAR;
    } else {
        PG8_STAGE(PG8_SB(0, 0), cB, voffB); PG8_STAGE(PG8_SA(0, 0), cA, voffA); PG8_STAGE(PG8_SB(0, 1), cB + hstep, voffB); PG8_STAGE(PG8_SA(0, 1), cA + hstep, voffA);
        if (wr == 1) PG8_BAR;
        PG8_WAIT_V(4); PG8_BAR;
        PG8_STAGE(PG8_SB(1, 0), cB + kstep, voffB); PG8_STAGE(PG8_SA(1, 0), cA + kstep, voffA); PG8_STAGE(PG8_SB(1, 1), cB + hstep + kstep, voffB);
        PG8_WAIT_V(6); PG8_BAR;
    }
    for (;;) {
        const bool has_next = S.next(ui + 1, nxt);
        const char* nA = has_next ? (const char*)g.A + (size_t)nxt.pm * tstep : cA; const char* nB = has_next ? (const char*)g.Bt + (size_t)nxt.pn * tstep : cB;
        for (int t = 0; t < nt; t += 2) {
            const bool last = (t == nt - 2);
            const char* a1 = cA + (size_t)(t + 1) * kstep;
            const char* a2 = last ? nA : cA + (size_t)(t + 2) * kstep; const char* b2 = last ? nB : cB + (size_t)(t + 2) * kstep;
            const char* a3 = a2 + kstep; const char* b3 = b2 + kstep;
            if (last && has_next) S.a_ready(nxt);
            if constexpr (SP2) {
            PG8_LDB(B0, 0, 0); PG8_LDB(B1, 0, 1); PG8_SCHED; PG8_LDA(At, 0, 0); PG8_STAGE(PG8_SA(1, 1), a1 + hstep, voffA);
            PG8_WAIT_V(8); PG8_WAIT_L(0); PG8_BAR; PG8_MMA(0, 0, At, B0); PG8_MMA(0, 1, At, B1); PG8_BAR; PG8_SCHED;
            PG8_LDA(At, 0, 1); PG8_STAGE(PG8_SB(0, 0), b2, voffB); PG8_STAGE(PG8_SB(0, 1), b2 + hstep, voffB); PG8_STAGE(PG8_SA(0, 0), a2, voffA);
            PG8_WAIT_V(8); PG8_WAIT_L(0); PG8_BAR; PG8_MMA(1, 0, At, B0); PG8_MMA(1, 1, At, B1); PG8_BAR; PG8_SCHED;
            PG8_LDB(B0, 1, 0); PG8_LDB(B1, 1, 1); PG8_SCHED; PG8_LDA(At, 1, 0); PG8_STAGE(PG8_SA(0, 1), a2 + hstep, voffA);
            PG8_WAIT_V(8); PG8_WAIT_L(0); PG8_BAR; PG8_MMA(0, 0, At, B0); PG8_MMA(0, 1, At, B1); PG8_BAR; PG8_SCHED;
            PG8_LDA(At, 1, 1); PG8_STAGE(PG8_SB(1, 0), b3, voffB); PG8_STAGE(PG8_SB(1, 1), b3 + hstep, voffB); PG8_STAGE(PG8_SA(1, 0), a3, voffA);
            PG8_WAIT_V(8); PG8_WAIT_L(0); PG8_BAR; PG8_MMA(1, 0, At, B0); PG8_MMA(1, 1, At, B1); PG8_BAR; PG8_SCHED;
            } else {
            PG8_LDB(B0, 0, 0); PG8_SCHED; PG8_LDA(At, 0, 0); PG8_STAGE(PG8_SA(1, 1), a1 + hstep, voffA);
            PG8_WAIT_L(8); PG8_BAR; PG8_WAIT_L(0); PG8_MMA(0, 0, At, B0); PG8_BAR; PG8_SCHED;
            PG8_LDB(B1, 0, 1); PG8_STAGE(PG8_SB(0, 0), b2, voffB);
            PG8_BAR; PG8_WAIT_L(0); PG8_MMA(0, 1, At, B1); PG8_BAR;
            PG8_LDA(At, 0, 1); PG8_STAGE(PG8_SA(0, 0), a2, voffA);
            PG8_BAR; PG8_WAIT_L(0); PG8_MMA(1, 0, At, B0); PG8_BAR; PG8_SCHED;
            PG8_STAGE(PG8_SB(0, 1), b2 + hstep, voffB);
            PG8_WAIT_V(6); PG8_BAR; PG8_MMA(1, 1, At, B1); PG8_BAR;
            PG8_LDB(B0, 1, 0); PG8_SCHED; PG8_LDA(At, 1, 0); PG8_STAGE(PG8_SA(0, 1), a2 + hstep, voffA);
            PG8_WAIT_L(8); PG8_BAR; PG8_WAIT_L(0); PG8_MMA(0, 0, At, B0); PG8_BAR; PG8_SCHED;
            PG8_LDB(B1, 1, 1); PG8_STAGE(PG8_SB(1, 0), b3, voffB);
            PG8_BAR; PG8_WAIT_L(0); PG8_MMA(0, 1, At, B1); PG8_BAR;
            PG8_LDA(At, 1, 1); PG8_STAGE(PG8_SA(1, 0), a3, voffA);
            PG8_BAR; PG8_WAIT_L(0); PG8_MMA(1, 0, At, B0); PG8_BAR; PG8_SCHED;
            PG8_STAGE(PG8_SB(1, 1), b3 + hstep, voffB);
            PG8_WAIT_V(6); PG8_BAR; PG8_MMA(1, 1, At, B1); PG8_BAR;
            }
        }
        if constexpr (ALIGN_EPI) { if (wr == 0) PG8_BAR; }
        if constexpr (!Epi::AFTER_DRAIN) { E(acc, cur, wr, wc, fr, fq); S.done(cur); }
        if (!has_next) break;
#pragma unroll
        for (int a = 0; a < 2; ++a)
#pragma unroll
            for (int b = 0; b < 2; ++b)
#pragma unroll
                for (int m = 0; m < 4; ++m)
#pragma unroll
                    for (int n = 0; n < 2; ++n) acc[a][b][m][n] = (f32x4){0.f, 0.f, 0.f, 0.f};
        cur = nxt; cA = nA; cB = nB; ++ui;
        if constexpr (ALIGN_EPI) { if (wr == 1) PG8_BAR; }
    }
    PG8_WAIT_V(0);
    if constexpr (!ALIGN_EPI) { if (wr == 0) PG8_BAR; }
    PG8_BAR;
    if constexpr (Epi::AFTER_DRAIN) { E.fused(acc, cur, wr, wc, fr, fq, lds, wid, lane); S.done(cur); }
#undef PG8_SA
#undef PG8_SB
#undef PG8_STAGE
#undef PG8_LDA
#undef PG8_LDB
#undef PG8_MMA
#undef PG8_WAIT_V
#undef PG8_WAIT_L
#undef PG8_BAR
#undef PG8_SCHED
}
}
#define LAS __attribute__((address_space(3)))
typedef unsigned short bf16;
typedef float f32x4 __attribute__((ext_vector_type(4)));
typedef unsigned u32x4 __attribute__((ext_vector_type(4)));
typedef unsigned u32x2 __attribute__((ext_vector_type(2)));
typedef short bf16x8 __attribute__((ext_vector_type(8)));
constexpr int NWAVES = 8, NTHR = 512;
constexpr int DM = 2048, MP = 8192, MS = 512, MT = 8704, SEQ = 2048;
constexpr int NCP = 5376, RC = 1696, C_S = 1696, C_H = 2720, C_P = 4768;
constexpr int DFF = 5632, PLED = 256;
constexpr int LDS_BYTES = 147456;
constexpr int NPH = 23;
constexpr size_t WL_BYTES = 109051904;
constexpr size_t WO_IN = 0, WO_OUT = 22020096, WO_GU = 30408704, WO_DN = 76546048, WO_GT = 99614720, WO_PL = 108003328;
constexpr size_t WS_PB = 2 * WL_BYTES;
constexpr size_t WS_XN = WS_PB + (size_t)2 * MT * 256 * 2;
constexpr size_t WS_A = WS_XN + (size_t)MT * 2048 * 2;
constexpr size_t WS_MIX = WS_A + (size_t)MT * DFF * 2;
constexpr size_t SZ = (size_t)MT * 512;
constexpr size_t WS_B = WS_A + (size_t)MT * NCP * 4;
constexpr size_t WS_PLE = WS_B, WS_XF = WS_B + (size_t)MT * 2048 * 4;
constexpr size_t WS_C = WS_XF + (size_t)MT * 2048 * 4;
constexpr size_t WS_END = WS_C + 7 * SZ * 4;
static_assert(WS_MIX + (size_t)MT * 2048 * 4 <= WS_B, "ws map A");
static_assert(7 * SZ * 4 + (size_t)MT * 8 * 4 <= (size_t)2 * MT * 2048 * 4, "ws map B");
static_assert(WS_END <= 738197504ull, "ws map end");
constexpr size_t O_Y = 0, O_WKV_P = 17825792, O_SH_P = 18087936, O_HG_P = 18101504, O_PL_P = 18625792, O_WKV_S = 18687232, O_SH_S = 27075840, O_HG_S = 27510016, O_PL_S = 44287232, O_SGV = 46253312;

struct Args { const float* in[38]; float* out; unsigned char* ws; int ph_lo, ph_hi; };

typedef const __attribute__((address_space(4))) Args* ArgP;
__device__ __forceinline__ ArgP largs() { ArgP p = (ArgP)__builtin_amdgcn_kernarg_segment_ptr(); asm volatile("" : "+s"(p)); return p; }
__device__ __forceinline__ unsigned pk2(float lo, float hi) { return pg8::cvt_pk_bf16(lo, hi); }
__device__ __forceinline__ bf16 bf1(float v) { return (bf16)(pg8::cvt_pk_bf16(v, 0.f) & 0xffffu); }
__device__ __forceinline__ float sigm(float x) { return 1.0f / (1.0f + __expf(-x)); }
__device__ __forceinline__ float gelu_erf(float x) { return 0.5f * x * (1.0f + erff(x * 0.70710678118f)); }
__device__ __forceinline__ float wave_sum(float v) {
#pragma unroll
    for (int o = 1; o < 64; o <<= 1) v += __shfl_xor(v, o);
    return v;
}
template <int CTRL> __device__ __forceinline__ float dpp_f(float v) { return __builtin_bit_cast(float, __builtin_amdgcn_update_dpp(0, __builtin_bit_cast(int, v), CTRL, 0xF, 0xF, true)); }
__device__ __forceinline__ float red8(float v) { v += dpp_f<0xB1>(v); v += dpp_f<0x4E>(v); v += dpp_f<0x141>(v); return v; }
__device__ __forceinline__ float red16(float v) { v = red8(v); v += dpp_f<0x140>(v); return v; }
__device__ __forceinline__ bf16x8 pack8(const float (&t)[8]) { u32x4 w; w.x = pk2(t[0], t[1]); w.y = pk2(t[2], t[3]); w.z = pk2(t[4], t[5]); w.w = pk2(t[6], t[7]); return __builtin_bit_cast(bf16x8, w); }
#define LDS_WAIT() asm volatile("s_waitcnt lgkmcnt(0)" ::: "memory")

__device__ __forceinline__ const float* xrow(ArgP A, int layer, int m) {
    if (layer > 0) return A->out + (size_t)m * DM;
    return (m < MP) ? A->in[0] + (size_t)m * DM : A->in[1] + (size_t)(m - MP) * DM;
}
__device__ __forceinline__ const float* prev_row(const float* Z, const float* shift_st, int m, float& mask) {
    mask = 1.f;
    if (m < MP) { if ((m & (SEQ - 1)) == 0) { mask = 0.f; return Z + (size_t)m * NCP; } return Z + (size_t)(m - 1) * NCP; }
    const int s = m - MP; if ((s & 3) == 0) return shift_st + (size_t)(s >> 2) * RC; return Z + (size_t)(m - 1) * NCP;
}
__device__ __forceinline__ void zm8(const float* zr, const float* pr, float msk, const float* mu, int col, float (&o)[8]) {
    const f32x4 z0 = *(const f32x4*)(zr + col), z1 = *(const f32x4*)(zr + col + 4), p0 = *(const f32x4*)(pr + col), p1 = *(const f32x4*)(pr + col + 4), u0 = *(const f32x4*)(mu + col), u1 = *(const f32x4*)(mu + col + 4);
#pragma unroll
    for (int i = 0; i < 4; ++i) { o[i] = z0[i] + u0[i] * (p0[i] * msk - z0[i]); o[4 + i] = z1[i] + u1[i] * (p1[i] * msk - z1[i]); }
}

__device__ __forceinline__ void p0_transpose_item(const float* W, int K, int N, bf16* WT, int mode, LAS float* scr, int item, int lane) {
    const int nblk = N / 32, kb = item / nblk, nb = item % nblk, k0 = 64 * kb, n0 = 32 * nb;
    int r0 = n0;
    if (mode == 1) { r0 = (n0 < DFF) ? (n0 / 128) * 256 + (n0 % 128) : ((n0 - DFF) / 128) * 256 + 128 + ((n0 - DFF) % 128); }
#pragma unroll 8
    for (int i = 0; i < 32; ++i) { const int kk = 2 * i + (lane >> 5); scr[kk * 33 + (lane & 31)] = W[(size_t)(k0 + kk) * N + n0 + (lane & 31)]; }
    LDS_WAIT();
    const int c = lane & 7;
#pragma unroll
    for (int j = 0; j < 4; ++j) { const int n = (lane >> 3) + 8 * j; const LAS float* s = scr + (8 * c) * 33 + n;
        u32x4 o; o.x = pk2(s[0 * 33], s[1 * 33]); o.y = pk2(s[2 * 33], s[3 * 33]); o.z = pk2(s[4 * 33], s[5 * 33]); o.w = pk2(s[6 * 33], s[7 * 33]);
        *(u32x4*)(WT + (size_t)(r0 + n) * K + k0 + 8 * c) = o; }
    LDS_WAIT();
}
__device__ __forceinline__ void row_rms_bf16(const float* x, const float* g, bf16* o, int lane) {
    f32x4 v[8]; float s = 0.f;
#pragma unroll
    for (int j = 0; j < 8; ++j) { v[j] = ((const f32x4*)x)[64 * j + lane]; s += (v[j].x * v[j].x + v[j].y * v[j].y) + (v[j].z * v[j].z + v[j].w * v[j].w); }
    const float r = rsqrtf(wave_sum(s) * (1.0f / DM) + 1e-6f);
#pragma unroll
    for (int j = 0; j < 8; ++j) { const f32x4 gg = ((const f32x4*)g)[64 * j + lane]; u32x2 w; w.x = pk2(v[j].x * r * gg.x, v[j].y * r * gg.y); w.y = pk2(v[j].z * r * gg.z, v[j].w * r * gg.w); ((u32x2*)o)[64 * j + lane] = w; }
}
__device__ __forceinline__ void p0_prologue(ArgP A, LAS unsigned char* lds, int tid, int lane, int wave, int bid, int G) {
    LAS float* scr = (LAS float*)(lds + wave * 16384);
    const int gw = bid * NWAVES + wave, NGW = G * NWAVES;
    constexpr int I_IN = 32 * 165, I_OUT = 32 * 64, I_GU = 32 * 352, I_DN = 88 * 64, I_GT = 32 * 64, I_PL = 4 * 64, I_L = I_IN + I_OUT + I_GU + I_DN + I_GT + I_PL;
    for (int it = gw; it < 2 * I_L; it += NGW) {
        const int layer = it / I_L; int r = it - layer * I_L;
        unsigned char* wb = A->ws + (size_t)layer * WL_BYTES;
        if (r < I_IN) { p0_transpose_item(A->in[12] + (size_t)layer * DM * 5280, DM, 5280, (bf16*)(wb + WO_IN), 0, scr, r, lane); continue; } r -= I_IN;
        if (r < I_OUT) { p0_transpose_item(A->in[33] + (size_t)layer * DM * DM, DM, DM, (bf16*)(wb + WO_OUT), 0, scr, r, lane); continue; } r -= I_OUT;
        if (r < I_GU) { p0_transpose_item(A->in[34] + (size_t)layer * DM * 2 * DFF, DM, 2 * DFF, (bf16*)(wb + WO_GU), 1, scr, r, lane); continue; } r -= I_GU;
        if (r < I_DN) { p0_transpose_item(A->in[35] + (size_t)layer * DFF * DM, DFF, DM, (bf16*)(wb + WO_DN), 0, scr, r, lane); continue; } r -= I_DN;
        if (r < I_GT) { p0_transpose_item(A->in[36] + (size_t)layer * DM * DM, DM, DM, (bf16*)(wb + WO_GT), 0, scr, r, lane); continue; } r -= I_GT;
        p0_transpose_item(A->in[37] + (size_t)layer * PLED * DM, PLED, DM, (bf16*)(wb + WO_PL), 0, scr, r, lane);
    }
    const int gt = bid * NTHR + tid, NGT = G * NTHR;
    for (int i = gt; i < 2 * 96 * 256; i += NGT) { const int layer = i / (96 * 256), r = i % (96 * 256); ((u32x4*)(A->ws + (size_t)layer * WL_BYTES + WO_IN + (size_t)5280 * DM * 2))[r] = (u32x4){0u, 0u, 0u, 0u}; }
    for (int i = gt; i < 2 * MT * 64; i += NGT) { const int layer = i / (MT * 64), rem = i % (MT * 64), m = rem >> 6, c4 = rem & 63;
        const float* src = (m < MP) ? A->in[6] + ((size_t)layer * MP + m) * PLED : A->in[7] + ((size_t)layer * MS + (m - MP)) * PLED;
        const f32x4 v = ((const f32x4*)src)[c4]; u32x2 w; w.x = pk2(v.x, v.y); w.y = pk2(v.z, v.w); ((u32x2*)(A->ws + WS_PB))[i] = w; }
    for (int m = gw; m < MT; m += NGW) row_rms_bf16(xrow(A, 0, m), A->in[8], (bf16*)(A->ws + WS_XN) + (size_t)m * DM, lane);
}

__device__ __forceinline__ void rowA_phase(ArgP A, int layer, int lane, int wave, int bid, int G) {
    for (int m = bid * NWAVES + wave; m < MT; m += G * NWAVES) row_rms_bf16(xrow(A, layer, m), A->in[8] + layer * DM, (bf16*)(A->ws + WS_XN) + (size_t)m * DM, lane);
}
__device__ __forceinline__ void rowB_phase(ArgP A, int layer, int lane, int wave, int bid, int G) {
    const float* gpost = A->in[9] + layer * DM; const float* gpre = A->in[10] + layer * DM;
    for (int m = bid * NWAVES + wave; m < MT; m += G * NWAVES) {
        const f32x4* x = (const f32x4*)xrow(A, layer, m); const f32x4* mx = (const f32x4*)(A->ws + WS_MIX) + (size_t)m * (DM / 4);
        f32x4 xv[8], mv[8]; float s = 0.f;
#pragma unroll
        for (int j = 0; j < 8; ++j) { xv[j] = x[64 * j + lane]; mv[j] = mx[64 * j + lane]; s += (mv[j].x * mv[j].x + mv[j].y * mv[j].y) + (mv[j].z * mv[j].z + mv[j].w * mv[j].w); }
        const float r1 = rsqrtf(wave_sum(s) * (1.0f / DM) + 1e-6f); float s2 = 0.f;
#pragma unroll
        for (int j = 0; j < 8; ++j) { const f32x4 g = ((const f32x4*)gpost)[64 * j + lane]; xv[j] = xv[j] + mv[j] * r1 * g; s2 += (xv[j].x * xv[j].x + xv[j].y * xv[j].y) + (xv[j].z * xv[j].z + xv[j].w * xv[j].w); }
        const float r2 = rsqrtf(wave_sum(s2) * (1.0f / DM) + 1e-6f);
        f32x4* xf = (f32x4*)(A->ws + WS_XF) + (size_t)m * (DM / 4); u32x2* xn = (u32x2*)(A->ws + WS_XN) + (size_t)m * (DM / 4);
#pragma unroll
        for (int j = 0; j < 8; ++j) { const f32x4 g = ((const f32x4*)gpre)[64 * j + lane]; xf[64 * j + lane] = xv[j];
            u32x2 w; w.x = pk2(xv[j].x * r2 * g.x, xv[j].y * r2 * g.y); w.y = pk2(xv[j].z * r2 * g.z, xv[j].w * r2 * g.w); xn[64 * j + lane] = w; }
    }
}
__device__ __forceinline__ void rowC_phase(ArgP A, int layer, int lane, int wave, int bid, int G) {
    const float* gpost = A->in[11] + layer * DM;
    for (int m = bid * NWAVES + wave; m < MT; m += G * NWAVES) {
        f32x4* xf = (f32x4*)(A->ws + WS_XF) + (size_t)m * (DM / 4); const f32x4* fx = (const f32x4*)(A->ws + WS_MIX) + (size_t)m * (DM / 4); u32x2* xn = (u32x2*)(A->ws + WS_XN) + (size_t)m * (DM / 4);
        f32x4 xv[8], mv[8]; float s = 0.f;
#pragma unroll
        for (int j = 0; j < 8; ++j) { xv[j] = xf[64 * j + lane]; mv[j] = fx[64 * j + lane]; s += (mv[j].x * mv[j].x + mv[j].y * mv[j].y) + (mv[j].z * mv[j].z + mv[j].w * mv[j].w); }
        const float r1 = rsqrtf(wave_sum(s) * (1.0f / DM) + 1e-6f);
#pragma unroll
        for (int j = 0; j < 8; ++j) { const f32x4 g = ((const f32x4*)gpost)[64 * j + lane]; const f32x4 o = xv[j] + mv[j] * r1 * g; xf[64 * j + lane] = o;
            u32x2 w; w.x = pk2(o.x, o.y); w.y = pk2(o.z, o.w); xn[64 * j + lane] = w; }
    }
}
__device__ __forceinline__ void m1_phase(ArgP A, int layer, LAS unsigned char* lds, int tid, int lane, int wave, int bid, int G) {
    const float* Z = (const float*)(A->ws + WS_A);
    float* RW = (float*)(A->ws + WS_B); float* RK = RW + 7 * SZ;
    float* U = (float*)(A->ws + WS_C) + SZ; float* VLN = U + SZ;
    const float* mu = A->in[13] + layer * RC; const float* wl = A->in[14] + layer * 32 * 512; const float* w0 = A->in[15] + layer * 512;
    const float* al = A->in[16] + layer * 32 * 512; const float* a0 = A->in[17] + layer * 512; const float* gl = A->in[18] + layer * 96 * 512;
    const float* kk_ = A->in[19] + layer * 512; const float* ka_ = A->in[20] + layer * 512; const float* rk_ = A->in[21] + layer * 512;
    const float* lnw = A->in[24] + layer * 512; const float* lnb = A->in[25] + layer * 512;
    const float* shift_st = A->in[3] + (size_t)layer * 128 * RC;
    const int c = lane & 15, quad = lane >> 4, h = wave;
    LAS float* part = (LAS float*)lds;
    for (int tile = bid; tile < MT / 16; tile += G) {
        const int m0 = tile * 16;
        f32x4 accw[4], acca[4], accg[4];
        {
            const int m = m0 + c; float msk; const float* zr = Z + (size_t)m * NCP; const float* pr = prev_row(Z, shift_st, m, msk);
            float t[8]; bf16x8 aw, aa, ag[3];
            zm8(zr, pr, msk, mu, 1536 + quad * 8, t);
#pragma unroll
            for (int j = 0; j < 8; ++j) t[j] = tanhf(t[j]);
            aw = pack8(t);
            zm8(zr, pr, msk, mu, 1568 + quad * 8, t); aa = pack8(t);
#pragma unroll
            for (int kk = 0; kk < 3; ++kk) { zm8(zr, pr, msk, mu, 1600 + kk * 32 + quad * 8, t);
#pragma unroll
                for (int j = 0; j < 8; ++j) t[j] = sigm(t[j]);
                ag[kk] = pack8(t); }
            const f32x4 zero = {0.f, 0.f, 0.f, 0.f};
#pragma unroll
            for (int ct = 0; ct < 4; ++ct) { int n = h * 64 + ct * 16 + c; asm volatile("" : "+v"(n)); float tb[8]; bf16x8 bfr;
                const float* wl_ = wl; const float* al_ = al; const float* gl_ = gl; asm volatile("" : "+s"(wl_), "+s"(al_), "+s"(gl_));
#pragma unroll
                for (int j = 0; j < 8; ++j) tb[j] = wl_[(quad * 8 + j) * 512 + n];
                bfr = pack8(tb); accw[ct] = __builtin_amdgcn_mfma_f32_16x16x32_bf16(aw, bfr, zero, 0, 0, 0);
#pragma unroll
                for (int j = 0; j < 8; ++j) tb[j] = al_[(quad * 8 + j) * 512 + n];
                bfr = pack8(tb); acca[ct] = __builtin_amdgcn_mfma_f32_16x16x32_bf16(aa, bfr, zero, 0, 0, 0);
                accg[ct] = zero;
#pragma unroll
                for (int kk = 0; kk < 3; ++kk) {
#pragma unroll
                    for (int j = 0; j < 8; ++j) tb[j] = gl_[(kk * 32 + quad * 8 + j) * 512 + n];
                    bfr = pack8(tb); accg[ct] = __builtin_amdgcn_mfma_f32_16x16x32_bf16(ag[kk], bfr, accg[ct], 0, 0, 0); } }
        }
        float vg[4][4];
#pragma unroll
        for (int jj = 0; jj < 4; ++jj) {
            const int m = m0 + quad * 4 + jj; float msk; const float* zr = Z + (size_t)m * NCP; const float* pr = prev_row(Z, shift_st, m, msk);
            float r_[4], km[4], v_[4], wd[4], as[4], kkv[4]; float nsq = 0.f, rks = 0.f, s1 = 0.f, s2 = 0.f;
#pragma unroll
            for (int ct = 0; ct < 4; ++ct) { const int n = h * 64 + ct * 16 + c;
                const float zr_r = zr[n], zr_k = zr[512 + n], zr_v = zr[1024 + n];
                r_[ct] = zr_r + mu[n] * (pr[n] * msk - zr_r);
                const float kraw = zr_k + mu[512 + n] * (pr[512 + n] * msk - zr_k);
                v_[ct] = zr_v + mu[1024 + n] * (pr[1024 + n] * msk - zr_v);
                wd[ct] = __expf(-0.6065306597f * sigm(w0[n] + accw[ct][jj]));
                as[ct] = sigm(a0[n] + acca[ct][jj]);
                kkv[ct] = kraw * kk_[n]; km[ct] = kraw * (1.0f + (as[ct] - 1.0f) * ka_[n]);
                nsq += kkv[ct] * kkv[ct]; rks += r_[ct] * km[ct] * rk_[n];
                U[(size_t)m * 512 + n] = gelu_erf(zr[C_S + n]);
                const float gv = gelu_erf(zr[C_S + 512 + n]); vg[jj][ct] = gv; s1 += gv; s2 += gv * gv; }
            nsq = red16(nsq); rks = red16(rks); s1 = red16(s1); s2 = red16(s2);
            const float inv = 1.0f / fmaxf(sqrtf(nsq), 1e-12f);
#pragma unroll
            for (int ct = 0; ct < 4; ++ct) { const size_t o = (size_t)m * 512 + h * 64 + ct * 16 + c; const float kn = kkv[ct] * inv;
                RW[o] = r_[ct]; RW[SZ + o] = wd[ct]; RW[2 * SZ + o] = km[ct]; RW[3 * SZ + o] = v_[ct]; RW[4 * SZ + o] = -kn; RW[5 * SZ + o] = kn * as[ct]; RW[6 * SZ + o] = accg[ct][jj]; }
            if (c == 0) { RK[m * 8 + h] = rks; part[(wave * 16 + quad * 4 + jj) * 2] = s1; part[(wave * 16 + quad * 4 + jj) * 2 + 1] = s2; }
            asm volatile("" ::: "memory");
        }
        __syncthreads();
#pragma unroll
        for (int jj = 0; jj < 4; ++jj) {
            const int tk = quad * 4 + jj, m = m0 + tk; float S1 = 0.f, S2 = 0.f;
#pragma unroll
            for (int w = 0; w < 8; ++w) { S1 += part[(w * 16 + tk) * 2]; S2 += part[(w * 16 + tk) * 2 + 1]; }
            const float mean = S1 * (1.0f / 512.0f), var = fmaxf(S2 * (1.0f / 512.0f) - mean * mean, 0.f), rstd = rsqrtf(var + 1e-5f);
#pragma unroll
            for (int ct = 0; ct < 4; ++ct) { const int n = h * 64 + ct * 16 + c; const float vl = (vg[jj][ct] - mean) * rstd * lnw[n] + lnb[n];
                VLN[(size_t)m * 512 + n] = vl; if (m >= MP) A->out[O_SGV + ((size_t)layer * MS + (m - MP)) * 512 + n] = vl; }
        }
#pragma unroll
        for (int tk = 3; tk < 16; tk += 4) { const int m = m0 + tk;
            const bool last = (m < MP) ? ((m & (SEQ - 1)) == SEQ - 1) : (((m - MP) & 3) == 3);
            if (last) { float* dst = (m < MP) ? A->out + O_SH_P + ((size_t)layer * 4 + (m >> 11)) * RC : A->out + O_SH_S + ((size_t)layer * 128 + ((m - MP) >> 2)) * RC;
                for (int cc = tid; cc < RC; cc += NTHR) dst[cc] = Z[(size_t)m * NCP + cc]; } }
        __syncthreads();
    }
}

__device__ __forceinline__ void rwkv_scan_rg(LAS float* buf, const float* RW, int mbase, int nsteps, int h, int rg, const float* Sinit, float* Sout, float* YR, int lane) {
    const int rl = lane >> 3, cgp = lane & 7;
    float S[8];
    if (Sinit) { const f32x4 s0 = *(const f32x4*)(Sinit + (rg * 8 + rl) * 64 + cgp * 8), s1 = *(const f32x4*)(Sinit + (rg * 8 + rl) * 64 + cgp * 8 + 4);
        S[0] = s0.x; S[1] = s0.y; S[2] = s0.z; S[3] = s0.w; S[4] = s1.x; S[5] = s1.y; S[6] = s1.z; S[7] = s1.w; }
    else {
#pragma unroll
        for (int i = 0; i < 8; ++i) S[i] = 0.f; }
    const float* gp = RW + (size_t)mbase * 512 + h * 64 + lane;
    float pre[24];
#pragma unroll
    for (int s = 0; s < 4; ++s)
#pragma unroll
        for (int q = 0; q < 6; ++q) pre[s * 6 + q] = gp[(size_t)q * SZ + s * 512];
#pragma unroll
    for (int i = 0; i < 24; ++i) buf[i * 64 + lane] = pre[i];
    const int nch = nsteps >> 2;
    for (int ci = 0; ci < nch; ++ci) {
        const bool more = ci + 1 < nch;
        if (more) { const float* g2 = gp + (size_t)(ci + 1) * 4 * 512;
#pragma unroll
            for (int s = 0; s < 4; ++s)
#pragma unroll
                for (int q = 0; q < 6; ++q) pre[s * 6 + q] = g2[(size_t)q * SZ + s * 512]; }
        LDS_WAIT();
        const LAS float* cb = buf + (ci & 1) * 1536;
#pragma unroll
        for (int s = 0; s < 4; ++s) { const LAS float* sb = cb + s * 384;
            const f32x4 r0 = *(const LAS f32x4*)(sb + cgp * 8), r1 = *(const LAS f32x4*)(sb + cgp * 8 + 4);
            const f32x4 w0 = *(const LAS f32x4*)(sb + 64 + cgp * 8), w1 = *(const LAS f32x4*)(sb + 64 + cgp * 8 + 4);
            const f32x4 k0 = *(const LAS f32x4*)(sb + 128 + cgp * 8), k1 = *(const LAS f32x4*)(sb + 128 + cgp * 8 + 4);
            const f32x4 a0 = *(const LAS f32x4*)(sb + 256 + cgp * 8), a1 = *(const LAS f32x4*)(sb + 256 + cgp * 8 + 4);
            const f32x4 b0 = *(const LAS f32x4*)(sb + 320 + cgp * 8), b1 = *(const LAS f32x4*)(sb + 320 + cgp * 8 + 4);
            const float vv = sb[192 + rg * 8 + rl];
            const float rr[8] = {r0.x, r0.y, r0.z, r0.w, r1.x, r1.y, r1.z, r1.w}, ww[8] = {w0.x, w0.y, w0.z, w0.w, w1.x, w1.y, w1.z, w1.w}, kx[8] = {k0.x, k0.y, k0.z, k0.w, k1.x, k1.y, k1.z, k1.w};
            const float ax[8] = {a0.x, a0.y, a0.z, a0.w, a1.x, a1.y, a1.z, a1.w}, bx[8] = {b0.x, b0.y, b0.z, b0.w, b1.x, b1.y, b1.z, b1.w};
            float sa = 0.f;
#pragma unroll
            for (int i = 0; i < 8; ++i) sa += S[i] * ax[i];
            sa = red8(sa);
            float y = 0.f;
#pragma unroll
            for (int i = 0; i < 8; ++i) { S[i] = S[i] * ww[i] + (sa * bx[i] + vv * kx[i]); y += S[i] * rr[i]; }
            y = red8(y);
            if (cgp == 0) YR[(size_t)(mbase + ci * 4 + s) * 512 + h * 64 + rg * 8 + rl] = y;
        }
        if (more) { LAS float* nb = buf + ((ci + 1) & 1) * 1536;
#pragma unroll
            for (int i = 0; i < 24; ++i) nb[i * 64 + lane] = pre[i]; }
    }
    float* so = Sout + (rg * 8 + rl) * 64 + cgp * 8;
    *(f32x4*)so = (f32x4){S[0], S[1], S[2], S[3]}; *(f32x4*)(so + 4) = (f32x4){S[4], S[5], S[6], S[7]};
}
__device__ __forceinline__ float hgrn_lb(const float* logits, int layer, int cfull) {
    if (layer == 0) return 0.f;
    return 1.0f / (1.0f + __expf(logits[cfull] - logits[512 + cfull]));
}
__device__ __forceinline__ void hgrn_prompt_job(LAS unsigned char* lds, const float* Z, const float* logits, int layer, int b, int h, int dq, float* OP, float* Sout, int tid, int lane, int wave) {
    LAS float* OPS = (LAS float*)lds;
    LAS float* VV = (LAS float*)(lds + 12288);
    LAS float* OPL = (LAS float*)(lds + 28672);
    const int st = tid >> 5, sd = tid & 31, cfull = h * 128 + dq * 32 + sd;
    const float lb = hgrn_lb(logits, layer, cfull);
    const int mbase = b * SEQ;
    const float* zq = Z + (size_t)mbase * NCP + C_H + cfull; const float* zf = zq + 512; const float* zv = Z + (size_t)mbase * NCP + C_H + 1024 + h * 128;
    const int slot = (st * 4 + (sd >> 3)) * 24 + (sd & 7);
    {   const float f = zf[(size_t)st * NCP], q = zq[(size_t)st * NCP], fg = lb + (1.0f - lb) * sigm(f);
        OPS[slot] = fg; OPS[slot + 8] = 1.0f - fg; OPS[slot + 16] = q * sigm(q);
#pragma unroll
        for (int i = 0; i < 4; ++i) { const int idx = tid + 512 * i; VV[idx] = zv[(size_t)(idx >> 7) * NCP + (idx & 127)]; } }
    __syncthreads();
    float S[8][2];
#pragma unroll
    for (int d = 0; d < 8; ++d) { S[d][0] = 0.f; S[d][1] = 0.f; }
    for (int ci = 0; ci < SEQ / 16; ++ci) {
        const bool more = ci + 1 < SEQ / 16; float pf = 0.f, pq = 0.f, pv[4] = {0.f, 0.f, 0.f, 0.f};
        if (more) { const size_t row = (size_t)(ci + 1) * 16; pf = zf[(row + st) * NCP]; pq = zq[(row + st) * NCP];
#pragma unroll
            for (int i = 0; i < 4; ++i) { const int idx = tid + 512 * i; pv[i] = zv[(row + (idx >> 7)) * NCP + (idx & 127)]; } }
        if (wave < 4) {
            const LAS float* co = OPS + (ci & 1) * 1536; const LAS float* cv = VV + (ci & 1) * 2048;
#pragma unroll 4
            for (int t = 0; t < 16; ++t) { const LAS float* ob = co + (t * 4 + wave) * 24;
                const f32x4 F0 = *(const LAS f32x4*)ob, F1 = *(const LAS f32x4*)(ob + 4), K0 = *(const LAS f32x4*)(ob + 8), K1 = *(const LAS f32x4*)(ob + 12), Q0 = *(const LAS f32x4*)(ob + 16), Q1 = *(const LAS f32x4*)(ob + 20);
                const float Fx[8] = {F0.x, F0.y, F0.z, F0.w, F1.x, F1.y, F1.z, F1.w}, Kx[8] = {K0.x, K0.y, K0.z, K0.w, K1.x, K1.y, K1.z, K1.w}, Qx[8] = {Q0.x, Q0.y, Q0.z, Q0.w, Q1.x, Q1.y, Q1.z, Q1.w};
                const float v0 = cv[t * 128 + lane], v1 = cv[t * 128 + 64 + lane]; float o0 = 0.f, o1 = 0.f;
#pragma unroll
                for (int d = 0; d < 8; ++d) { S[d][0] = Fx[d] * S[d][0] + Kx[d] * v0; S[d][1] = Fx[d] * S[d][1] + Kx[d] * v1; o0 += Qx[d] * S[d][0]; o1 += Qx[d] * S[d][1]; }
                OPL[(t * 4 + wave) * 128 + lane] = o0; OPL[(t * 4 + wave) * 128 + 64 + lane] = o1; }
        }
        if (more) { LAS float* no = OPS + ((ci + 1) & 1) * 1536; LAS float* nv = VV + ((ci + 1) & 1) * 2048;
            const float fg = lb + (1.0f - lb) * sigm(pf); no[slot] = fg; no[slot + 8] = 1.0f - fg; no[slot + 16] = pq * sigm(pq);
#pragma unroll
            for (int i = 0; i < 4; ++i) nv[tid + 512 * i] = pv[i]; }
        __syncthreads();
#pragma unroll
        for (int i = 0; i < 4; ++i) { const int idx = tid + 512 * i, t = idx >> 7, v = idx & 127;
            const float s = (OPL[(t * 4 + 0) * 128 + v] + OPL[(t * 4 + 1) * 128 + v]) + (OPL[(t * 4 + 2) * 128 + v] + OPL[(t * 4 + 3) * 128 + v]);
            OP[(size_t)dq * SZ + (size_t)(mbase + ci * 16 + t) * 512 + h * 128 + v] = s; }
        __syncthreads();
    }
    if (wave < 4) {
#pragma unroll
        for (int d = 0; d < 8; ++d) { Sout[(dq * 32 + wave * 8 + d) * 128 + lane] = S[d][0]; Sout[(dq * 32 + wave * 8 + d) * 128 + 64 + lane] = S[d][1]; } }
}
__device__ __forceinline__ void hgrn_sample_wave(LAS float* buf, const float* Z, const float* logits, int layer, int b, int h, int vh, const float* Sin, float* Sout, float* OP0, int lane) {
    const int mbase = MP + b * 4;
#pragma unroll
    for (int t = 0; t < 4; ++t)
#pragma unroll
        for (int dd = 0; dd < 2; ++dd) { const int d = lane + 64 * dd, cfull = h * 128 + d; const float lb = hgrn_lb(logits, layer, cfull);
            const float q = Z[(size_t)(mbase + t) * NCP + C_H + cfull], f = Z[(size_t)(mbase + t) * NCP + C_H + 512 + cfull], fg = lb + (1.0f - lb) * sigm(f);
            *(LAS f32x4*)(buf + (t * 128 + d) * 4) = (f32x4){fg, 1.0f - fg, q * sigm(q), 0.f}; }
    float vt[4], o[4];
#pragma unroll
    for (int t = 0; t < 4; ++t) { vt[t] = Z[(size_t)(mbase + t) * NCP + C_H + 1024 + h * 128 + vh * 64 + lane]; o[t] = 0.f; }
    LDS_WAIT();
    for (int dc = 0; dc < 16; ++dc) { float S[8];
#pragma unroll
        for (int dd = 0; dd < 8; ++dd) S[dd] = Sin[(dc * 8 + dd) * 128 + vh * 64 + lane];
#pragma unroll
        for (int t = 0; t < 4; ++t)
#pragma unroll
            for (int dd = 0; dd < 8; ++dd) { const f32x4 op = *(const LAS f32x4*)(buf + (t * 128 + dc * 8 + dd) * 4); S[dd] = op.x * S[dd] + op.y * vt[t]; o[t] += op.z * S[dd]; }
#pragma unroll
        for (int dd = 0; dd < 8; ++dd) Sout[(dc * 8 + dd) * 128 + vh * 64 + lane] = S[dd]; }
#pragma unroll
    for (int t = 0; t < 4; ++t) OP0[(size_t)(mbase + t) * 512 + h * 128 + vh * 64 + lane] = o[t];
    LDS_WAIT();
}
__device__ __forceinline__ void sgu_job(LAS unsigned char* lds, const float* Wh, const float* sbias, const float* VLN, float* U, int m0, int h, int tid) {
    LAS float* WL = (LAS float*)lds;
    LAS float* VT = (LAS float*)(lds + 67584);
#pragma unroll 4
    for (int i = 0; i < 32; ++i) { const int idx = tid + 512 * i, t = idx >> 7, s = idx & 127;
        WL[t * 132 + s] = (s <= t) ? Wh[idx] : 0.f; VT[idx] = VLN[(size_t)(m0 + t) * 512 + h * 128 + s]; }
    __syncthreads();
    const int t0 = (tid >> 4) * 4, d0 = (tid & 15) * 8;
    float acc[4][8];
#pragma unroll
    for (int i = 0; i < 4; ++i)
#pragma unroll
        for (int j = 0; j < 8; ++j) acc[i][j] = 0.f;
    for (int s = 0; s <= t0 + 3; ++s) {
        const f32x4 v0 = *(const LAS f32x4*)(VT + s * 128 + d0), v1 = *(const LAS f32x4*)(VT + s * 128 + d0 + 4);
#pragma unroll
        for (int i = 0; i < 4; ++i) { const float w = WL[(t0 + i) * 132 + s];
            acc[i][0] += w * v0.x; acc[i][1] += w * v0.y; acc[i][2] += w * v0.z; acc[i][3] += w * v0.w; acc[i][4] += w * v1.x; acc[i][5] += w * v1.y; acc[i][6] += w * v1.z; acc[i][7] += w * v1.w; }
    }
#pragma unroll
    for (int i = 0; i < 4; ++i) { const int t = t0 + i; const float bias = sbias[t]; float* up = U + (size_t)(m0 + t) * 512 + h * 128 + d0;
        f32x4 u0 = *(const f32x4*)up, u1 = *(const f32x4*)(up + 4);
        u0.x *= acc[i][0] + bias; u0.y *= acc[i][1] + bias; u0.z *= acc[i][2] + bias; u0.w *= acc[i][3] + bias; u1.x *= acc[i][4] + bias; u1.y *= acc[i][5] + bias; u1.z *= acc[i][6] + bias; u1.w *= acc[i][7] + bias;
        *(f32x4*)up = u0; *(f32x4*)(up + 4) = u1; }
    __syncthreads();
}
__device__ __forceinline__ void m2_phase(ArgP A, int layer, LAS unsigned char* lds, int tid, int lane, int wave, int bid, int G) {
    const float* Z = (const float*)(A->ws + WS_A);
    const float* RW = (const float*)(A->ws + WS_B);
    float* YR = (float*)(A->ws + WS_C); float* U = YR + SZ; const float* VLN = U + SZ; float* OP = YR + 3 * SZ;
    const float* logits = A->in[29];
    for (int job = bid; job < 256; job += G) { const int b = job >> 6, n = (job >> 2) & 15, h = job & 3;
        sgu_job(lds, A->in[26] + ((size_t)layer * 4 + h) * 128 * 128, A->in[27] + (layer * 4 + h) * 128, VLN, U, b * SEQ + n * 128, h, tid); }
    LAS float* wbuf = (LAS float*)(lds + wave * 12288);
    for (int gw = bid * NWAVES + wave; gw < 2048; gw += G * NWAVES) {
        if (gw < 1024) { const int b = gw >> 3, h = gw & 7; const size_t so = (((size_t)layer * 128 + b) * 8 + h) * 4096;
            for (int rg = 0; rg < 8; ++rg) rwkv_scan_rg(wbuf, RW, MP + b * 4, 4, h, rg, A->in[2] + so, A->out + O_WKV_S + so, YR, lane); }
        else { const int j = gw - 1024, b = j >> 3, h = (j >> 1) & 3, vh = j & 1; const size_t so = (((size_t)layer * 128 + b) * 4 + h) * 16384;
            hgrn_sample_wave(wbuf, Z, logits, layer, b, h, vh, A->in[4] + so, A->out + O_HG_S + so, OP, lane); }
    }
    __syncthreads();
    const int Gh = G >> 1;
    if (bid < Gh) {
        if (wave < 2) for (int job = bid * 2 + wave; job < 256; job += Gh * 2) { const int b = job >> 6, h = (job >> 3) & 7, rg = job & 7;
            rwkv_scan_rg(wbuf, RW, b * SEQ, SEQ, h, rg, nullptr, A->out + O_WKV_P + (((size_t)layer * 4 + b) * 8 + h) * 4096, YR, lane); }
    } else {
        for (int job = bid - Gh; job < 64; job += G - Gh) { const int b = job >> 4, h = (job >> 2) & 3, dq = job & 3;
            hgrn_prompt_job(lds, Z, logits, layer, b, h, dq, OP, A->out + O_HG_P + (((size_t)layer * 4 + b) * 4 + h) * 16384, tid, lane, wave); }
    }
}

__device__ __forceinline__ void m3_phase(ArgP A, int layer, LAS unsigned char* lds, int tid, int lane, int wave, int bid, int G) {
    const float* Z = (const float*)(A->ws + WS_A);
    const float* RW = (const float*)(A->ws + WS_B); const float* RK = RW + 7 * SZ;
    const float* YR = (const float*)(A->ws + WS_C); const float* U = YR + SZ; const float* VLN = U + SZ; const float* OP = YR + 3 * SZ;
    bf16* YC = (bf16*)(A->ws + WS_XN);
    const float* gnw = A->in[22] + layer * 512; const float* gnb = A->in[23] + layer * 512; const float* sguw = A->in[26] + (size_t)layer * 4 * 128 * 128; const float* sgub = A->in[27] + layer * 512;
    const float* sgun = A->in[28] + layer * 512; const float* hgn = A->in[30] + layer * 512; const float* pw = A->in[31] + (size_t)layer * 4 * 128 * 128; const float* psc = A->in[32] + layer * 512;
    const float* pst = A->in[5] + (size_t)layer * 128 * 15 * 512;
    LAS float* P1 = (LAS float*)lds; LAS float* P2 = P1 + 128; LAS float* DT = (LAS float*)(lds + 1024);
    const int j = tid, wv = wave, hh = j >> 7, c = lane & 15, quad = lane >> 4, g = wv >> 1, colbase = (wv & 1) * 64;
    bf16x8 bp[4][4];
#pragma unroll
    for (int kk = 0; kk < 4; ++kk)
#pragma unroll
        for (int ct = 0; ct < 4; ++ct) { float t[8];
#pragma unroll
            for (int jj = 0; jj < 8; ++jj) t[jj] = pw[(size_t)(g * 128 + kk * 32 + quad * 8 + jj) * 128 + colbase + ct * 16 + c];
            bp[kk][ct] = pack8(t); }
    const int win = 2 << hh;
    for (int tile = bid; tile < MT / 16; tile += G) {
        const int m0 = tile * 16;
        float us_t[16], o_t[16];
#pragma unroll
        for (int t = 0; t < 16; ++t) {
            const int m = m0 + t; const size_t mo = (size_t)m * 512 + j;
            {
                const float y = YR[mo]; const float mean = wave_sum(y) * (1.0f / 64.0f); const float dv = y - mean; const float var = wave_sum(dv * dv) * (1.0f / 64.0f);
                const float yn = dv * rsqrtf(var + 64e-5f) * gnw[j] + gnb[j];
                YC[(size_t)m * DM + j] = bf1((yn + RK[m * 8 + wv] * RW[3 * SZ + mo]) * RW[6 * SZ + mo]); }
            {
                float u = U[mo];
                if (m >= MP) { const int ts = (m - MP) & 3; float s = sgub[hh * 128 + ts];
                    for (int sp = 0; sp <= ts; ++sp) s += sguw[(hh * 128 + ts) * 128 + sp] * VLN[(size_t)(m - ts + sp) * 512 + j];
                    u *= s; }
                us_t[t] = u; const float q = wave_sum(u * u); if (lane == 0) P1[t * 8 + wv] = q; }
            {
                float o = OP[mo]; if (m < MP) o += OP[SZ + mo] + OP[2 * SZ + mo] + OP[3 * SZ + mo];
                o_t[t] = o; const float q = wave_sum(o * o); if (lane == 0) P2[t * 8 + wv] = q; }
            {
                const float zp = Z[(size_t)m * NCP + C_P + j]; float sum = 0.f, cnt;
                if (m < MP) { const int tq = m & (SEQ - 1), lim = tq < win - 1 ? tq : win - 1;
                    for (int i = 0; i <= lim; ++i) sum += Z[(size_t)(m - i) * NCP + C_P + j];
                    cnt = (float)(lim + 1);
                    if (tq >= SEQ - 15) A->out[O_PL_P + (((size_t)layer * 4 + (m >> 11)) * 15 + (tq - (SEQ - 15))) * 512 + j] = zp;
                } else { const int s = m - MP, ts = s & 3, bq = s >> 2;
                    for (int i = 0; i < win; ++i) sum += (i <= ts) ? Z[(size_t)(m - i) * NCP + C_P + j] : pst[((size_t)bq * 15 + 15 + ts - i) * 512 + j];
                    cnt = (float)win;
                    if (ts == 3) for (int i = 0; i < 15; ++i) A->out[O_PL_S + (((size_t)layer * 128 + bq) * 15 + i) * 512 + j] = (i < 11) ? pst[((size_t)bq * 15 + i + 4) * 512 + j] : Z[(size_t)(m - 3 + (i - 11)) * NCP + C_P + j];
                }
                DT[t * 512 + j] = sum / cnt - zp; }
        }
        __syncthreads();
#pragma unroll
        for (int t = 0; t < 16; ++t) { const int m = m0 + t;
            float s1 = 0.f;
#pragma unroll
            for (int w = 0; w < 8; ++w) s1 += P1[t * 8 + w];
            YC[(size_t)m * DM + 512 + j] = bf1(us_t[t] * rsqrtf(s1 * (1.0f / 512.0f) + 1e-6f) * sgun[j]);
            const float s2 = P2[t * 8 + (wv & ~1)] + P2[t * 8 + (wv | 1)]; const float gz = Z[(size_t)m * NCP + C_H + 1536 + j];
            YC[(size_t)m * DM + 1024 + j] = bf1(o_t[t] * rsqrtf(s2 * (1.0f / 128.0f) + 1e-6f) * hgn[j] * gz * sigm(gz)); }
        {
            bf16x8 ap[4];
#pragma unroll
            for (int kk = 0; kk < 4; ++kk) { const LAS float* dp = DT + c * 512 + g * 128 + kk * 32 + quad * 8; const f32x4 d0 = *(const LAS f32x4*)dp, d1 = *(const LAS f32x4*)(dp + 4);
                const float t[8] = {d0.x, d0.y, d0.z, d0.w, d1.x, d1.y, d1.z, d1.w}; ap[kk] = pack8(t); }
#pragma unroll
            for (int ct = 0; ct < 4; ++ct) { f32x4 acc = {0.f, 0.f, 0.f, 0.f};
#pragma unroll
                for (int kk = 0; kk < 4; ++kk) acc = __builtin_amdgcn_mfma_f32_16x16x32_bf16(ap[kk], bp[kk][ct], acc, 0, 0, 0);
                const int col = g * 128 + colbase + ct * 16 + c; const float sc = psc[col];
#pragma unroll
                for (int jj = 0; jj < 4; ++jj) YC[(size_t)(m0 + quad * 4 + jj) * DM + 1536 + col] = bf1(acc[jj] * sc); }
        }
        __syncthreads();
    }
}
#ifndef MK_MULTI
#define MK_MULTI 1
#endif
__global__ void __launch_bounds__(NTHR, 2) mega_fwd(Args A_unused) {
    extern __shared__ __attribute__((aligned(16))) unsigned char lds_[];
    cg::grid_group grid = cg::this_grid();
    LAS unsigned char* lds = (LAS unsigned char*)lds_;
    const int bid = blockIdx.x, G = gridDim.x;
#define TL const int tid = ltid(), lane = tid & 63, wave = __builtin_amdgcn_readfirstlane(tid >> 6); (void)tid; (void)lane; (void)wave;
    int lo, hi; { ArgP A = largs(); lo = A->ph_lo; hi = A->ph_hi; }
#define GEMM_PRE ArgP A = largs(); unsigned char* wb = A->ws + (size_t)layer * WL_BYTES; const bf16* XN = (const bf16*)(A->ws + WS_XN);
#define INP(k) (lo <= (k) && (k) < hi)
#define SEAM(k) do { if (lo <= (k) && (k) + 1 < hi) grid.sync(); } while (0)
#ifndef SKIP_P0
    if (INP(0)) { TL p0_prologue(largs(), lds, tid, lane, wave, bid, G); }
#endif
    SEAM(0);
#pragma unroll
    for (int layer = 0; layer < 2; ++layer) {
        const int pb = 1 + layer * 11;
        if (layer > 0) { if (INP(pb + 0)) { TL rowA_phase(largs(), layer, lane, wave, bid, G); } SEAM(pb + 0); }
        if (INP(pb + 1)) {
            GEMM_PRE
            pg8::Gemm g{XN, (const bf16*)(wb + WO_IN), MT, NCP, DM}; pg8::StaticOrder S; S.init(MT, NCP, G, bid);
            pg8::EpiF32 E{(float*)(A->ws + WS_A), NCP};
#ifndef SKIP_G1
            pg8::gemm_phase<pg8::EpiF32, pg8::StaticOrder, true, true>(lds, g, S, E);
#endif
 }
        SEAM(pb + 1);
#ifndef SKIP_M1
        if (INP(pb + 2)) { TL m1_phase(largs(), layer, lds, tid, lane, wave, bid, G); }
#endif
        SEAM(pb + 2);
#ifndef SKIP_M2
        if (INP(pb + 3)) { TL m2_phase(largs(), layer, lds, tid, lane, wave, bid, G); }
#endif
        SEAM(pb + 3);
#ifndef SKIP_M3
        if (INP(pb + 4)) { TL m3_phase(largs(), layer, lds, tid, lane, wave, bid, G); }
#endif
        SEAM(pb + 4);
        if (INP(pb + 5)) {
            GEMM_PRE
            { pg8::Gemm g{XN, (const bf16*)(wb + WO_OUT), MT, DM, DM}; pg8::StaticOrder S; S.init(MT, DM, G, bid);
              pg8::EpiF32 E{(float*)(A->ws + WS_MIX), DM};
#ifndef SKIP_GO
              pg8::gemm_phase<pg8::EpiF32, pg8::StaticOrder, true, true>(lds, g, S, E);
#endif
 }
            { pg8::Gemm g{(const bf16*)(A->ws + WS_PB) + (size_t)layer * MT * PLED, (const bf16*)(wb + WO_PL), MT, DM, PLED}; pg8::StaticOrder S; S.init(MT, DM, G, (bid + 128) % G);
              pg8::EpiF32 E{(float*)(A->ws + WS_PLE), DM};
#ifndef SKIP_GP
              pg8::gemm_phase<pg8::EpiF32, pg8::StaticOrder, true, true>(lds, g, S, E);
#endif
 } }
        SEAM(pb + 5);
        if (INP(pb + 6)) { TL rowB_phase(largs(), layer, lane, wave, bid, G); }
        SEAM(pb + 6);
        if (INP(pb + 7)) {
            GEMM_PRE
            pg8::Gemm g{XN, (const bf16*)(wb + WO_GU), MT, 2 * DFF, DM}; pg8::StaticOrder S; S.init(MT, 2 * DFF, G, bid);
            pg8::EpiSwiglu E{(bf16*)(A->ws + WS_A), DFF};
#ifndef SKIP_GU
            pg8::gemm_phase<pg8::EpiSwiglu, pg8::StaticOrder, true, true>(lds, g, S, E);
#endif
 }
        SEAM(pb + 7);
        if (INP(pb + 8)) {
            GEMM_PRE
            pg8::Gemm g{(const bf16*)(A->ws + WS_A), (const bf16*)(wb + WO_DN), MT, DM, DFF}; pg8::StaticOrder S; S.init(MT, DM, G, bid);
            pg8::EpiF32 E{(float*)(A->ws + WS_MIX), DM};
#ifndef SKIP_GD
            pg8::gemm_phase<pg8::EpiF32, pg8::StaticOrder, true, true>(lds, g, S, E);
#endif
 }
        SEAM(pb + 8);
        if (INP(pb + 9)) { TL rowC_phase(largs(), layer, lane, wave, bid, G); }
        SEAM(pb + 9);
        if (INP(pb + 10)) {  GEMM_PRE
            pg8::Gemm g{XN, (const bf16*)(wb + WO_GT), MT, DM, DM}; pg8::StaticOrder S; S.init(MT, DM, G, bid);
            pg8::EpiGate E{(const float*)(A->ws + WS_XF), (const float*)(A->ws + WS_PLE), A->out + O_Y, DM};
#ifndef SKIP_GG
            pg8::gemm_phase<pg8::EpiGate, pg8::StaticOrder, true, true>(lds, g, S, E);
#endif
 }
        if (layer == 0) SEAM(pb + 10);
    }
#undef INP
#undef SEAM
}

extern "C" void kernel_launch(void* const* d_in, const int* in_sizes, int n_in, void* d_out, int out_size, void* d_ws, size_t ws_size, hipStream_t stream) {
    static int grid = 0;
    if (grid == 0) {
        if (n_in != 38 || out_size != 46777600 || ws_size < WS_END) { fprintf(stderr, "kernel_launch: unexpected shapes (n_in %d, out %d, ws %zu < %zu); nothing launched\n", n_in, out_size, ws_size, (size_t)WS_END); grid = -1; return; }
        int dev = 0, cus = 0, per_cu = 0;
        (void)hipGetDevice(&dev); (void)hipDeviceGetAttribute(&cus, hipDeviceAttributeMultiprocessorCount, dev);
        if (hipFuncSetAttribute((const void*)mega_fwd, hipFuncAttributeMaxDynamicSharedMemorySize, LDS_BYTES) != hipSuccess) { fprintf(stderr, "kernel_launch: hipFuncSetAttribute failed\n"); grid = -1; return; }
        if (hipOccupancyMaxActiveBlocksPerMultiprocessor(&per_cu, (const void*)mega_fwd, NTHR, LDS_BYTES) != hipSuccess || per_cu < 1) { fprintf(stderr, "kernel_launch: occupancy query says %d workgroups per CU\n", per_cu); per_cu = 1; }
        (void)hipGetLastError();
        grid = cus * 1;
        if (grid < 2) grid = 2;
    }
    if (grid < 0) return;
    Args a{};
    for (int i = 0; i < 38; ++i) a.in[i] = (const float*)d_in[i];
    a.out = (float*)d_out; a.ws = (unsigned char*)d_ws;
#if MK_MULTI
    for (int ph = 0; ph < NPH; ++ph) { if (ph == 1) continue; a.ph_lo = ph; a.ph_hi = ph + 1; void* args[] = {&a};
        hipError_t e = hipLaunchCooperativeKernel((const void*)mega_fwd, dim3(grid), dim3(NTHR), args, LDS_BYTES, stream);
        if (e != hipSuccess) { fprintf(stderr, "kernel_launch: launch of phase %d failed: %s\n", ph, hipGetErrorString(e)); break; } }
#else
    a.ph_lo = 0; a.ph_hi = NPH; void* args[] = {&a};
    hipError_t e = hipLaunchCooperativeKernel((const void*)mega_fwd, dim3(grid), dim3(NTHR), args, LDS_BYTES, stream);
    if (e != hipSuccess) fprintf(stderr, "kernel_launch: cooperative launch failed: %s (grid %d)\n", hipGetErrorString(e), grid);
#endif
}
```

```cpp
#include <hip/hip_runtime.h>
#include <hip/hip_cooperative_groups.h>
#include <cstdio>
#include <cstdint>
namespace cg = cooperative_groups;
__device__ __forceinline__ int ltid() { int t = threadIdx.x; asm volatile("" : "+v"(t)); return t; }
#ifndef REP_M2
#define REP_M2 1
#endif
#ifndef REP_RWKV
#define REP_RWKV 1
#endif
#ifndef REP_HGRN
#define REP_HGRN 1
#endif
namespace pg8 {
#define PG8_LAS __attribute__((address_space(3)))
typedef unsigned short bf16_t;
typedef short bf16x8 __attribute__((ext_vector_type(8)));
typedef float f32x4 __attribute__((ext_vector_type(4)));
typedef unsigned u32x4 __attribute__((ext_vector_type(4)));
constexpr int BM = 256, BK = 64, HALF = 128, HTB = HALF * BK * 2  , STAGE_BYTES = 8 * HTB, NXCD = 8, WGM = 8;

__host__ __device__ __forceinline__ int lds_byte(int r, int c) { const int st = (r >> 4) * 2 + (c >> 5), rr = r & 15, cc = c & 31, ob = rr * 64 + cc * 2; return st * 1024 + (ob ^ (((ob >> 9) & 1) << 5)); }
__host__ __device__ __forceinline__ void stage_rc(int b, int& R, int& C) { const int st = b / 1024, sb = b % 1024, swz = sb ^ (((sb >> 9) & 1) << 5); R = (st >> 1) * 16 + swz / 64; C = (st & 1) * 32 + (swz % 64) / 2; }
__host__ __device__ __forceinline__ int perm32(int rho) { const int n = rho >> 4, i = rho & 15; return 8 * (i >> 2) + 4 * n + (i & 3); }

struct Unit { int pm, pn, k0; };
struct Gemm { const bf16_t* A; const bf16_t* Bt; int M, N, K, ld; };

struct StaticOrder {
    int nM, nN, nwg, G, c;
    __host__ __device__ void init(int M, int N, int G_, int c_) { nM = M / BM; nN = N / BM; nwg = nM * nN; G = G_; c = c_; }
    __host__ __device__ bool next(int i, Unit& u) const {
        const long L = (long)i * G + c; if (L >= nwg) return false;
        int wgid = (int)L; { const int q = nwg / NXCD, r = nwg % NXCD, xcd = wgid % NXCD, off = wgid / NXCD; wgid = (xcd < r ? xcd * (q + 1) : r * (q + 1) + (xcd - r) * q) + off; }
        const int nig = WGM * nN, gid = wgid / nig, fm = gid * WGM, gsz = (nM - fm) < WGM ? (nM - fm) : WGM;
        u.pm = fm + ((wgid % nig) % gsz); u.pn = (wgid % nig) / gsz; u.k0 = 0; return true;
    }
    __device__ __forceinline__ void a_ready(const Unit&) const {}
    __device__ __forceinline__ void done(const Unit&) const {}
};

__device__ __forceinline__ unsigned cvt_pk_bf16(float lo, float hi) { unsigned r; asm volatile("v_cvt_pk_bf16_f32 %0, %1, %2" : "=v"(r) : "v"(lo), "v"(hi)); return r; }
struct TailOrder {
    int c, S_, kr, pm0;
    __host__ __device__ void init(int c_, int s, int krange, int pm0_) { c = c_; S_ = s; kr = krange; pm0 = pm0_; }
    __host__ __device__ bool next(int i, Unit& u) const { if (i > 0 || c >= 16 * S_) return false; const int t = c / S_, ks = c - t * S_; u.pm = pm0 + (t >> 3); u.pn = t & 7; u.k0 = ks * kr; return true; }
    __device__ __forceinline__ void a_ready(const Unit&) const {}
    __device__ __forceinline__ void done(const Unit&) const {}
};
struct EpiF32 {
    static constexpr bool PERM = false, AFTER_DRAIN = false;
    float* O; int ldc;
    __device__ __forceinline__ void operator()(const f32x4 (&acc)[2][2][4][2], const Unit& u, int wr, int wc, int fr, int fq) const {
#pragma unroll
        for (int ai = 0; ai < 2; ++ai)
#pragma unroll
            for (int m = 0; m < 4; ++m) { float* rowp = O + (size_t)(u.pm * BM + ai * HALF + wr * 64 + m * 16 + fr) * ldc + u.pn * BM + wc * 32 + 4 * fq;
#pragma unroll
                for (int bj = 0; bj < 2; ++bj)
#pragma unroll
                    for (int n = 0; n < 2; ++n) *(__attribute__((address_space(1))) f32x4*)(rowp + bj * HALF + n * 16) = acc[ai][bj][m][n]; }
    }
};
struct EpiSwiglu {
    static constexpr bool PERM = false, AFTER_DRAIN = false;
    bf16_t* O; int ldc;
    __device__ __forceinline__ void operator()(const f32x4 (&acc)[2][2][4][2], const Unit& u, int wr, int wc, int fr, int fq) const {
        typedef unsigned u32x2 __attribute__((ext_vector_type(2)));
#pragma unroll
        for (int ai = 0; ai < 2; ++ai)
#pragma unroll
            for (int m = 0; m < 4; ++m) { bf16_t* rowp = O + (size_t)(u.pm * BM + ai * HALF + wr * 64 + m * 16 + fr) * ldc + u.pn * HALF + wc * 32 + 4 * fq;
#pragma unroll
                for (int n = 0; n < 2; ++n) { const f32x4 g = acc[ai][0][m][n], up = acc[ai][1][m][n]; float h[4];
#pragma unroll
                    for (int j = 0; j < 4; ++j) h[j] = g[j] / (1.0f + __expf(-g[j])) * up[j];
                    u32x2 w; w.x = cvt_pk_bf16(h[0], h[1]); w.y = cvt_pk_bf16(h[2], h[3]); *(__attribute__((address_space(1))) u32x2*)(rowp + n * 16) = w; } }
    }
};
struct EpiGate {
    static constexpr bool PERM = false, AFTER_DRAIN = false;
    const float* XF; const float* PL; float* O; int ldc;
    __device__ __forceinline__ void operator()(const f32x4 (&acc)[2][2][4][2], const Unit& u, int wr, int wc, int fr, int fq) const {
#pragma unroll
        for (int ai = 0; ai < 2; ++ai)
#pragma unroll
            for (int m = 0; m < 4; ++m) { const size_t off = (size_t)(u.pm * BM + ai * HALF + wr * 64 + m * 16 + fr) * ldc + u.pn * BM + wc * 32 + 4 * fq;
#pragma unroll
                for (int bj = 0; bj < 2; ++bj)
#pragma unroll
                    for (int n = 0; n < 2; ++n) { const size_t o2 = off + bj * HALF + n * 16; const f32x4 a = acc[ai][bj][m][n], xf = __builtin_nontemporal_load((const __attribute__((address_space(1))) f32x4*)(XF + o2)), pl = __builtin_nontemporal_load((const __attribute__((address_space(1))) f32x4*)(PL + o2)); f32x4 o;
#pragma unroll
                        for (int j = 0; j < 4; ++j) o[j] = xf[j] + pl[j] / (1.0f + __expf(-a[j]));
                        *(__attribute__((address_space(1))) f32x4*)(O + o2) = o; } }
    }
};
struct EpiF32P {
    static constexpr bool PERM = true, AFTER_DRAIN = false;
    float* O; int ldc;
    __device__ __forceinline__ void operator()(const f32x4 (&acc)[2][2][4][2], const Unit& u, int wr, int wc, int fr, int fq) const {
#pragma unroll
        for (int ai = 0; ai < 2; ++ai)
#pragma unroll
            for (int m = 0; m < 4; ++m) { float* rowp = O + (size_t)(u.pm * BM + ai * HALF + wr * 64 + m * 16 + fr) * ldc + u.pn * BM + wc * 32 + 8 * fq;
#pragma unroll
                for (int bj = 0; bj < 2; ++bj)
#pragma unroll
                    for (int n = 0; n < 2; ++n) *(__attribute__((address_space(1))) f32x4*)(rowp + bj * HALF + n * 4) = acc[ai][bj][m][n]; }
    }
};

template <class Epi, class Sched, bool ALIGN_EPI = false, bool SP2 = false>
__device__ __forceinline__ void gemm_phase(PG8_LAS unsigned char* lds, const Gemm g, const Sched& S, const Epi& E) {
    const int tid = ltid(), wid = __builtin_amdgcn_readfirstlane(tid >> 6), lane = tid & 63, wr = wid >> 2, wc = wid & 3, fr = lane & 15, fq = lane >> 4;
    const int K = g.K, nt = K / BK, ld = g.ld;
    unsigned voffA[2], voffB[2];
#pragma unroll
    for (int i = 0; i < 2; ++i) { int R, C; stage_rc(tid * 16 + i * 8192, R, C); const int Rb = Epi::PERM ? ((R & ~31) + perm32(R & 31)) : R;
        voffA[i] = (unsigned)(R * ld + C) * 2u; voffB[i] = (unsigned)(Rb * ld + C) * 2u; }
    const size_t kstep = (size_t)(BK * 2);
    const size_t hstep = (size_t)HALF * ld * 2;
    const size_t tstep = 2 * hstep;
    const unsigned ldsw = (unsigned)wid * 1024u;
    const int aoff = lds_byte(wr * 64 + fr, fq * 8), boff = lds_byte(wc * 32 + fr, fq * 8);
#define PG8_SA(b, h) (((b) * 2 + (h)) * HTB)
#define PG8_SB(b, h) ((4 + (b) * 2 + (h)) * HTB)
#define PG8_STAGE(bufoff, gbase, voff) do { _Pragma("unroll") for (int _i = 0; _i < 2; ++_i) \
        __builtin_amdgcn_global_load_lds((const unsigned*)((const char*)(gbase) + (voff)[_i]), (PG8_LAS unsigned*)(lds + (bufoff) + ldsw + _i * 8192), 16, 0, 0); } while (0)
#define PG8_LDA(dst, b, h) do { _Pragma("unroll") for (int m = 0; m < 4; ++m) _Pragma("unroll") for (int k = 0; k < 2; ++k) dst[m][k] = *(const PG8_LAS bf16x8*)(lds + PG8_SA(b, h) + aoff + m * 2048 + k * 1024); } while (0)
#define PG8_LDB(dst, b, h) do { _Pragma("unroll") for (int n = 0; n < 2; ++n) _Pragma("unroll") for (int k = 0; k < 2; ++k) dst[n][k] = *(const PG8_LAS bf16x8*)(lds + PG8_SB(b, h) + boff + n * 2048 + k * 1024); } while (0)
#define PG8_MMA(ai, bj, At, Bt) do { __builtin_amdgcn_s_setprio(1); _Pragma("unroll") for (int m = 0; m < 4; ++m) _Pragma("unroll") for (int n = 0; n < 2; ++n) _Pragma("unroll") for (int k = 0; k < 2; ++k) \
        acc[ai][bj][m][n] = __builtin_amdgcn_mfma_f32_16x16x32_bf16(Bt[n][k], At[m][k], acc[ai][bj][m][n], 0, 0, 0); __builtin_amdgcn_s_setprio(0); } while (0)
#define PG8_WAIT_V(n) asm volatile("s_waitcnt vmcnt(" #n ")" ::: "memory")
#define PG8_WAIT_L(n) asm volatile("s_waitcnt lgkmcnt(" #n ")" ::: "memory")
#define PG8_BAR __builtin_amdgcn_s_barrier()
#define PG8_SCHED __builtin_amdgcn_sched_barrier(0)
    Unit cur, nxt; int ui = 0;
    if (!S.next(0, cur)) return;
    f32x4 acc[2][2][4][2];
#pragma unroll
    for (int a = 0; a < 2; ++a)
#pragma unroll
        for (int b = 0; b < 2; ++b)
#pragma unroll
            for (int m = 0; m < 4; ++m)
#pragma unroll
                for (int n = 0; n < 2; ++n) acc[a][b][m][n] = (f32x4){0.f, 0.f, 0.f, 0.f};
    bf16x8 At[4][2], B0[2][2], B1[2][2];
    const char* cA = (const char*)g.A + (size_t)cur.pm * tstep + (size_t)cur.k0 * 2; const char* cB = (const char*)g.Bt + (size_t)cur.pn * tstep + (size_t)cur.k0 * 2;
    S.a_ready(cur);
    if constexpr (SP2) {
        PG8_STAGE(PG8_SB(0, 0), cB, voffB); PG8_STAGE(PG8_SB(0, 1), cB + hstep, voffB); PG8_STAGE(PG8_SA(0, 0), cA, voffA); PG8_STAGE(PG8_SA(0, 1), cA + hstep, voffA);
        if (wr == 1) PG8_BAR;
        PG8_WAIT_V(2); PG8_BAR;
        PG8_STAGE(PG8_SB(1, 0), cB + kstep, voffB); PG8_STAGE(PG8_SA(1, 0), cA + kstep, voffA); PG8_STAGE(PG8_SB(1, 1), cB + hstep + kstep, voffB);
        PG8_WAIT_V(6); PG8_BAR;
    } else {
        PG8_STAGE(PG8_SB(0, 0), cB, voffB); PG8_STAGE(PG8_SA(0, 0), cA, voffA); PG8_STAGE(PG8_SB(0, 1), cB + hstep, voffB); PG8_STAGE(PG8_SA(0, 1), cA + hstep, voffA);
        if (wr == 1) PG8_BAR;
        PG8_WAIT_V(4); PG8_BAR;
        PG8_STAGE(PG8_SB(1, 0), cB + kstep, voffB); PG8_STAGE(PG8_SA(1, 0), cA + kstep, voffA); PG8_STAGE(PG8_SB(1, 1), cB + hstep + kstep, voffB);
        PG8_WAIT_V(6); PG8_BAR;
    }
    for (;;) {
        const bool has_next = S.next(ui + 1, nxt);
        const char* nA = has_next ? (const char*)g.A + (size_t)nxt.pm * tstep + (size_t)nxt.k0 * 2 : cA; const char* nB = has_next ? (const char*)g.Bt + (size_t)nxt.pn * tstep + (size_t)nxt.k0 * 2 : cB;
        for (int t = 0; t < nt; t += 2) {
            const bool last = (t == nt - 2);
            const char* a1 = cA + (size_t)(t + 1) * kstep;
            const char* a2 = last ? nA : cA + (size_t)(t + 2) * kstep; const char* b2 = last ? nB : cB + (size_t)(t + 2) * kstep;
            const char* a3 = a2 + kstep; const char* b3 = b2 + kstep;
            if (last && has_next) S.a_ready(nxt);
            if constexpr (SP2) {
            PG8_LDB(B0, 0, 0); PG8_LDB(B1, 0, 1); PG8_SCHED; PG8_LDA(At, 0, 0); PG8_STAGE(PG8_SA(1, 1), a1 + hstep, voffA);
            PG8_WAIT_V(8); PG8_WAIT_L(0); PG8_BAR; PG8_MMA(0, 0, At, B0); PG8_MMA(0, 1, At, B1); PG8_BAR; PG8_SCHED;
            PG8_LDA(At, 0, 1); PG8_STAGE(PG8_SB(0, 0), b2, voffB); PG8_STAGE(PG8_SB(0, 1), b2 + hstep, voffB); PG8_STAGE(PG8_SA(0, 0), a2, voffA);
            PG8_WAIT_V(8); PG8_WAIT_L(0); PG8_BAR; PG8_MMA(1, 0, At, B0); PG8_MMA(1, 1, At, B1); PG8_BAR; PG8_SCHED;
            PG8_LDB(B0, 1, 0); PG8_LDB(B1, 1, 1); PG8_SCHED; PG8_LDA(At, 1, 0); PG8_STAGE(PG8_SA(0, 1), a2 + hstep, voffA);
            PG8_WAIT_V(8); PG8_WAIT_L(0); PG8_BAR; PG8_MMA(0, 0, At, B0); PG8_MMA(0, 1, At, B1); PG8_BAR; PG8_SCHED;
            PG8_LDA(At, 1, 1); PG8_STAGE(PG8_SB(1, 0), b3, voffB); PG8_STAGE(PG8_SB(1, 1), b3 + hstep, voffB); PG8_STAGE(PG8_SA(1, 0), a3, voffA);
            PG8_WAIT_V(8); PG8_WAIT_L(0); PG8_BAR; PG8_MMA(1, 0, At, B0); PG8_MMA(1, 1, At, B1); PG8_BAR; PG8_SCHED;
            } else {
            PG8_LDB(B0, 0, 0); PG8_SCHED; PG8_LDA(At, 0, 0); PG8_STAGE(PG8_SA(1, 1), a1 + hstep, voffA);
            PG8_WAIT_L(8); PG8_BAR; PG8_WAIT_L(0); PG8_MMA(0, 0, At, B0); PG8_BAR; PG8_SCHED;
            PG8_LDB(B1, 0, 1); PG8_STAGE(PG8_SB(0, 0), b2, voffB);
            PG8_BAR; PG8_WAIT_L(0); PG8_MMA(0, 1, At, B1); PG8_BAR;
            PG8_LDA(At, 0, 1); PG8_STAGE(PG8_SA(0, 0), a2, voffA);
            PG8_BAR; PG8_WAIT_L(0); PG8_MMA(1, 0, At, B0); PG8_BAR; PG8_SCHED;
            PG8_STAGE(PG8_SB(0, 1), b2 + hstep, voffB);
            PG8_WAIT_V(6); PG8_BAR; PG8_MMA(1, 1, At, B1); PG8_BAR;
            PG8_LDB(B0, 1, 0); PG8_SCHED; PG8_LDA(At, 1, 0); PG8_STAGE(PG8_SA(0, 1), a2 + hstep, voffA);
            PG8_WAIT_L(8); PG8_BAR; PG8_WAIT_L(0); PG8_MMA(0, 0, At, B0); PG8_BAR; PG8_SCHED;
            PG8_LDB(B1, 1, 1); PG8_STAGE(PG8_SB(1, 0), b3, voffB);
            PG8_BAR; PG8_WAIT_L(0); PG8_MMA(0, 1, At, B1); PG8_BAR;
            PG8_LDA(At, 1, 1); PG8_STAGE(PG8_SA(1, 0), a3, voffA);
            PG8_BAR; PG8_WAIT_L(0); PG8_MMA(1, 0, At, B0); PG8_BAR; PG8_SCHED;
            PG8_STAGE(PG8_SB(1, 1), b3 + hstep, voffB);
            PG8_WAIT_V(6); PG8_BAR; PG8_MMA(1, 1, At, B1); PG8_BAR;
            }
        }
        if constexpr (ALIGN_EPI) { if (wr == 0) PG8_BAR; }
        if constexpr (!Epi::AFTER_DRAIN) { E(acc, cur, wr, wc, fr, fq); S.done(cur); }
        if (!has_next) break;
#pragma unroll
        for (int a = 0; a < 2; ++a)
#pragma unroll
            for (int b = 0; b < 2; ++b)
#pragma unroll
                for (int m = 0; m < 4; ++m)
#pragma unroll
                    for (int n = 0; n < 2; ++n) acc[a][b][m][n] = (f32x4){0.f, 0.f, 0.f, 0.f};
        cur = nxt; cA = nA; cB = nB; ++ui;
        if constexpr (ALIGN_EPI) { if (wr == 1) PG8_BAR; }
    }
    PG8_WAIT_V(0);
    if constexpr (!ALIGN_EPI) { if (wr == 0) PG8_BAR; }
    PG8_BAR;
    if constexpr (Epi::AFTER_DRAIN) { E.fused(acc, cur, wr, wc, fr, fq, lds, wid, lane); S.done(cur); }
#undef PG8_SA
#undef PG8_SB
#undef PG8_STAGE
#undef PG8_LDA
#undef PG8_LDB
#undef PG8_MMA
#undef PG8_WAIT_V
#undef PG8_WAIT_L
#undef PG8_BAR
#undef PG8_SCHED
}
}
#define LAS __attribute__((address_space(3)))
#define GAS __attribute__((address_space(1)))
typedef unsigned short bf16;
typedef float f32x4 __attribute__((ext_vector_type(4)));
typedef unsigned u32x4 __attribute__((ext_vector_type(4)));
typedef unsigned u32x2 __attribute__((ext_vector_type(2)));
typedef short bf16x8 __attribute__((ext_vector_type(8)));
constexpr int NWAVES = 8, NTHR = 512;
constexpr int DM = 2048, MP = 8192, MS = 512, MT = 8704, SEQ = 2048;
constexpr int NCP = 5376, RC = 1696, C_S = 1696, C_H = 2720, C_P = 4768;
constexpr int DFF = 5632, PLED = 256;
constexpr int LDS_BYTES = 147456;
constexpr int NPH = 24;
constexpr size_t WL_BYTES = 109051904;
constexpr size_t WO_IN = 0, WO_OUT = 22020096, WO_GU = 30408704, WO_DN = 76546048, WO_GT = 99614720, WO_PL = 108003328;
constexpr size_t WS_PB = 2 * WL_BYTES;
constexpr size_t WS_XN = WS_PB + (size_t)2 * MT * 256 * 2;
constexpr size_t WS_A = WS_XN + (size_t)MT * 2048 * 2;
constexpr size_t WS_MIX = WS_A + (size_t)MT * DFF * 2;
constexpr size_t SZ = (size_t)MT * 512;
constexpr size_t WS_B = WS_A + (size_t)MT * NCP * 4;
constexpr size_t WS_PLE = WS_B, WS_XF = WS_B + (size_t)MT * 2048 * 4;
constexpr size_t WS_C = WS_XF + (size_t)MT * 2048 * 4;
constexpr size_t WS_CTL = WS_C + 7 * SZ * 4, CTL_BYTES = 16384;
constexpr size_t WS_END = WS_CTL + CTL_BYTES;
static_assert(WS_MIX + (size_t)MT * 2048 * 4 <= WS_B, "ws map A");
static_assert(7 * SZ * 4 + (size_t)MT * 8 * 4 <= (size_t)2 * MT * 2048 * 4, "ws map B");
static_assert(WS_END <= 738197504ull, "ws map end");
constexpr size_t O_Y = 0, O_WKV_P = 17825792, O_SH_P = 18087936, O_HG_P = 18101504, O_PL_P = 18625792, O_WKV_S = 18687232, O_SH_S = 27075840, O_HG_S = 27510016, O_PL_S = 44287232, O_SGV = 46253312;

struct Args { const float* in[38]; float* out; unsigned char* ws; int ph_lo, ph_hi; };
struct ArgsD { const GAS float* in[38]; GAS float* out; GAS unsigned char* ws; int ph_lo, ph_hi; };

typedef const __attribute__((address_space(4))) ArgsD* ArgP;
__device__ __forceinline__ ArgP largs() { ArgP p = (ArgP)__builtin_amdgcn_kernarg_segment_ptr(); asm volatile("" : "+s"(p)); return p; }
__device__ __forceinline__ unsigned pk2(float lo, float hi) { return pg8::cvt_pk_bf16(lo, hi); }
__device__ __forceinline__ bf16 bf1(float v) { return (bf16)(pg8::cvt_pk_bf16(v, 0.f) & 0xffffu); }
__device__ __forceinline__ float sigm(float x) { return 1.0f / (1.0f + __expf(-x)); }
__device__ __forceinline__ float gelu_erf(float x) { return 0.5f * x * (1.0f + erff(x * 0.70710678118f)); }
template <int CTRL> __device__ __forceinline__ float dpp_f(float v) { return __builtin_bit_cast(float, __builtin_amdgcn_update_dpp(0, __builtin_bit_cast(int, v), CTRL, 0xF, 0xF, true)); }
__device__ __forceinline__ float red8(float v) { v += dpp_f<0xB1>(v); v += dpp_f<0x4E>(v); v += dpp_f<0x141>(v); return v; }
__device__ __forceinline__ float red16(float v) { v = red8(v); v += dpp_f<0x140>(v); return v; }
__device__ __forceinline__ bf16x8 pack8(const float (&t)[8]) { u32x4 w; w.x = pk2(t[0], t[1]); w.y = pk2(t[2], t[3]); w.z = pk2(t[4], t[5]); w.w = pk2(t[6], t[7]); return __builtin_bit_cast(bf16x8, w); }
__device__ __forceinline__ float rdlane(float v, int l) { return __builtin_bit_cast(float, __builtin_amdgcn_readlane(__builtin_bit_cast(int, v), l)); }
__device__ __forceinline__ float wave_sum(float v) { v = red16(v); return (rdlane(v, 0) + rdlane(v, 16)) + (rdlane(v, 32) + rdlane(v, 48)); }
#define LDS_WAIT() asm volatile("s_waitcnt lgkmcnt(0)" ::: "memory")

#define XB_TMO      128
#define XB_XCNT(j)  (256  + 64 * (j))
#define XB_XSUB(j)  (1280 + 64 * (j))
#define XB_XGEN(j)  (2304 + 64 * (j))
#define XB_TOP      3328
#define XB_TOPGEN   3392
#define XCD_BAR_WORDS 3456
#define XB_SPIN_CAP (1u << 18)

__device__ __forceinline__ unsigned xb_ld(unsigned* p)              { return __hip_atomic_load(p, __ATOMIC_RELAXED, __HIP_MEMORY_SCOPE_AGENT); }
__device__ __forceinline__ unsigned xb_add(unsigned* p, unsigned v) { return __hip_atomic_fetch_add(p, v, __ATOMIC_RELAXED, __HIP_MEMORY_SCOPE_AGENT); }
__device__ __forceinline__ unsigned xb_xcc_id() { return (unsigned)__builtin_amdgcn_s_getreg((3 << 11) | 20) & 0xFu; }
#define XB_SPIN(cond, bar) do { unsigned _sp = 0; while (cond) { __builtin_amdgcn_s_sleep(1); \
    if ((++_sp & 255u) == 0u) { if (xb_ld(&(bar)[XB_TMO])) break; if (_sp > XB_SPIN_CAP) { atomicAdd(&(bar)[XB_TMO], 1u); break; } } } } while (0)

struct XcdBarrier {
    unsigned* bar; unsigned x;
    volatile LAS unsigned* st;
};

__device__ __forceinline__ XcdBarrier xcd_barrier_post(unsigned* bar, volatile LAS unsigned* st) {
    XcdBarrier b; b.bar = bar; b.x = xb_xcc_id(); b.st = st;
    if (threadIdx.x == 0) (void)xb_add(&bar[XB_XCNT(b.x)], 1u);
    return b;
}
__device__ __forceinline__ void xcd_barrier_complete(unsigned* bar, unsigned x, unsigned& nloc, unsigned& nx) {
    const unsigned G = gridDim.x * gridDim.y * gridDim.z;
    unsigned sum, cnt, mine, sp = 0u;
    for (;;) {
        sum = 0u; cnt = 0u; mine = 0u;
#pragma unroll
        for (unsigned j = 0; j < 16; ++j) { const unsigned c = xb_ld(&bar[XB_XCNT(j)]); sum += c; cnt += (c > 0u) ? 1u : 0u; mine = (j == x) ? c : mine; }
        if (sum == G) break;
        __builtin_amdgcn_s_sleep(1);
        if ((++sp & 255u) == 0u) { if (xb_ld(&bar[XB_TMO])) break; if (sp > XB_SPIN_CAP) { atomicAdd(&bar[XB_TMO], 1u); break; } }
    }
    nloc = mine > 0u ? mine : 1u; nx = cnt > 0u ? cnt : 1u;
}

__device__ __forceinline__ void xcd_barrier(const XcdBarrier& b) {
    asm volatile("s_waitcnt vmcnt(0)" ::: "memory");
    __syncthreads();
    if (threadIdx.x == 0) {
        unsigned* bar = b.bar;
        __builtin_amdgcn_s_waitcnt(0);
        unsigned nloc = b.st[0], nx = b.st[1];
        if (nloc == 0u) { xcd_barrier_complete(bar, b.x, nloc, nx); b.st[0] = nloc; b.st[1] = nx; }
        const unsigned old = xb_add(&bar[XB_XSUB(b.x)], 1u);
        const unsigned gen = old / nloc;
        if (old + 1u == (gen + 1u) * nloc) {
            __builtin_amdgcn_fence(__ATOMIC_RELEASE, "agent");
            asm volatile("s_waitcnt vmcnt(0)" ::: "memory");
            const unsigned og = xb_add(&bar[XB_TOP], 1u);
            const unsigned tg = og / nx;
            if (og + 1u == (tg + 1u) * nx) xb_add(&bar[XB_TOPGEN], 1u);
            else XB_SPIN(xb_ld(&bar[XB_TOPGEN]) == tg, bar);
            __builtin_amdgcn_fence(__ATOMIC_ACQUIRE, "agent");
            xb_add(&bar[XB_XGEN(b.x)], 1u);
            asm volatile("s_waitcnt vmcnt(0)" ::: "memory");
        } else {
            XB_SPIN(xb_ld(&bar[XB_XGEN(b.x)]) == gen, bar);
            __builtin_amdgcn_fence(__ATOMIC_ACQUIRE, "agent");
            asm volatile("s_waitcnt vmcnt(0)" ::: "memory");
        }
    }
    __syncthreads();
}

__device__ __forceinline__ const GAS float* xrow(ArgP A, int layer, int m) {
    if (layer > 0) return A->out + (size_t)m * DM;
    return (m < MP) ? A->in[0] + (size_t)m * DM : A->in[1] + (size_t)(m - MP) * DM;
}
__device__ __forceinline__ const GAS float* prev_row(const GAS float* Z, const GAS float* shift_st, int m, float& mask) {
    mask = 1.f;
    if (m < MP) { if ((m & (SEQ - 1)) == 0) { mask = 0.f; return Z + (size_t)m * NCP; } return Z + (size_t)(m - 1) * NCP; }
    const int s = m - MP; if ((s & 3) == 0) return shift_st + (size_t)(s >> 2) * RC; return Z + (size_t)(m - 1) * NCP;
}
__device__ __forceinline__ void zm8(const GAS float* zr, const GAS float* pr, float msk, const GAS float* mu, int col, float (&o)[8]) {
    const f32x4 z0 = *(const GAS f32x4*)(zr + col), z1 = *(const GAS f32x4*)(zr + col + 4), p0 = *(const GAS f32x4*)(pr + col), p1 = *(const GAS f32x4*)(pr + col + 4), u0 = *(const GAS f32x4*)(mu + col), u1 = *(const GAS f32x4*)(mu + col + 4);
#pragma unroll
    for (int i = 0; i < 4; ++i) { o[i] = z0[i] + u0[i] * (p0[i] * msk - z0[i]); o[4 + i] = z1[i] + u1[i] * (p1[i] * msk - z1[i]); }
}

__device__ __forceinline__ void p0_transpose_item(const GAS float* W, int K, int N, GAS bf16* WT, int mode, LAS float* scr, int item, int lane) {
    const int nblk = N / 32, kb = item / nblk, nb = item % nblk, k0 = 64 * kb, n0 = 32 * nb;
    int r0 = n0;
    if (mode & 1) { r0 = (n0 < DFF) ? (n0 / 128) * 256 + (n0 % 128) : ((n0 - DFF) / 128) * 256 + 128 + ((n0 - DFF) % 128); }
    float tv[32];
#pragma unroll
    for (int i = 0; i < 32; ++i) tv[i] = __builtin_nontemporal_load(&W[(size_t)(k0 + 2 * i + (lane >> 5)) * N + n0 + (lane & 31)]);
#pragma unroll
    for (int i = 0; i < 32; ++i) scr[(2 * i + (lane >> 5)) * 33 + (lane & 31)] = tv[i];
    LDS_WAIT();
    const int c = lane & 7;
#pragma unroll
    for (int j = 0; j < 4; ++j) { const int n = (lane >> 3) + 8 * j; const LAS float* s = scr + (8 * c) * 33 + n;
        u32x4 o; o.x = pk2(s[0 * 33], s[1 * 33]); o.y = pk2(s[2 * 33], s[3 * 33]); o.z = pk2(s[4 * 33], s[5 * 33]); o.w = pk2(s[6 * 33], s[7 * 33]);
        if (mode & 2) __builtin_nontemporal_store(o, (GAS u32x4*)(WT + (size_t)(r0 + n) * K + k0 + 8 * c)); else *(GAS u32x4*)(WT + (size_t)(r0 + n) * K + k0 + 8 * c) = o; }
    LDS_WAIT();
}
template <bool NT = false> __device__ __forceinline__ void row_rms_bf16(const GAS float* x, const GAS float* g, GAS bf16* o, int lane) {
    f32x4 v[8]; float s = 0.f;
#pragma unroll
    for (int j = 0; j < 8; ++j) { v[j] = NT ? __builtin_nontemporal_load(&((const GAS f32x4*)x)[64 * j + lane]) : ((const GAS f32x4*)x)[64 * j + lane]; s += (v[j].x * v[j].x + v[j].y * v[j].y) + (v[j].z * v[j].z + v[j].w * v[j].w); }
    const float r = rsqrtf(wave_sum(s) * (1.0f / DM) + 1e-6f);
#pragma unroll
    for (int j = 0; j < 8; ++j) { const f32x4 gg = ((const GAS f32x4*)g)[64 * j + lane]; u32x2 w; w.x = pk2(v[j].x * r * gg.x, v[j].y * r * gg.y); w.y = pk2(v[j].z * r * gg.z, v[j].w * r * gg.w); ((GAS u32x2*)o)[64 * j + lane] = w; }
}
__device__ __forceinline__ void p0_prologue(ArgP A, LAS unsigned char* lds, int tid, int lane, int wave, int bid, int G) {
    LAS float* scr = (LAS float*)(lds + wave * 16384);
    const int gw = bid * NWAVES + wave, NGW = G * NWAVES;
    constexpr int I_IN = 32 * 165, I_OUT = 32 * 64, I_GU = 32 * 352, I_DN = 88 * 64, I_GT = 32 * 64, I_PL = 4 * 64, I_L = I_IN + I_OUT + I_GU + I_DN + I_GT + I_PL;
    for (int it = gw; it < 2 * I_L; it += NGW) {
        const int layer = it / I_L; int r = it - layer * I_L;
        GAS unsigned char* wb = A->ws + (size_t)layer * WL_BYTES;
        if (r < I_IN) { p0_transpose_item(A->in[12] + (size_t)layer * DM * 5280, DM, 5280, (GAS bf16*)(wb + WO_IN), 0 | (layer ? 2 : 0), scr, r, lane); continue; } r -= I_IN;
        if (r < I_OUT) { p0_transpose_item(A->in[33] + (size_t)layer * DM * DM, DM, DM, (GAS bf16*)(wb + WO_OUT), 0 | (layer ? 2 : 0), scr, r, lane); continue; } r -= I_OUT;
        if (r < I_GU) { p0_transpose_item(A->in[34] + (size_t)layer * DM * 2 * DFF, DM, 2 * DFF, (GAS bf16*)(wb + WO_GU), 1 | (layer ? 2 : 0), scr, r, lane); continue; } r -= I_GU;
        if (r < I_DN) { p0_transpose_item(A->in[35] + (size_t)layer * DFF * DM, DFF, DM, (GAS bf16*)(wb + WO_DN), 0 | (layer ? 2 : 0), scr, r, lane); continue; } r -= I_DN;
        if (r < I_GT) { p0_transpose_item(A->in[36] + (size_t)layer * DM * DM, DM, DM, (GAS bf16*)(wb + WO_GT), 0 | (layer ? 2 : 0), scr, r, lane); continue; } r -= I_GT;
        p0_transpose_item(A->in[37] + (size_t)layer * PLED * DM, PLED, DM, (GAS bf16*)(wb + WO_PL), 0 | (layer ? 2 : 0), scr, r, lane);
    }
    const int gt = bid * NTHR + tid, NGT = G * NTHR;
    for (int i = gt; i < 2 * 96 * 256; i += NGT) { const int layer = i / (96 * 256), r = i % (96 * 256); ((GAS u32x4*)(A->ws + (size_t)layer * WL_BYTES + WO_IN + (size_t)5280 * DM * 2))[r] = (u32x4){0u, 0u, 0u, 0u}; }
    for (int i = gt; i < 2 * MT * 64; i += NGT) { const int layer = i / (MT * 64), rem = i % (MT * 64), m = rem >> 6, c4 = rem & 63;
        const GAS float* src = (m < MP) ? A->in[6] + ((size_t)layer * MP + m) * PLED : A->in[7] + ((size_t)layer * MS + (m - MP)) * PLED;
        const f32x4 v = __builtin_nontemporal_load(&((const GAS f32x4*)src)[c4]); u32x2 w; w.x = pk2(v.x, v.y); w.y = pk2(v.z, v.w); ((GAS u32x2*)(A->ws + WS_PB))[i] = w; }
    for (int m = gw; m < MT; m += NGW) row_rms_bf16<true>(xrow(A, 0, m), A->in[8], (GAS bf16*)(A->ws + WS_XN) + (size_t)m * DM, lane);
}

__device__ __forceinline__ void part_sum(const GAS unsigned char* ws, int m, int ns, int lane, f32x4 (&v)[8]) {
    const GAS f32x4* p = (const GAS f32x4*)(ws + WS_C) + (size_t)(m - MP) * (DM / 4);
#pragma unroll
    for (int j = 0; j < 8; ++j) v[j] = p[64 * j + lane];
#pragma unroll 1
    for (int s = 1; s < ns; ++s) { p += (size_t)MS * (DM / 4); asm volatile("" : "+v"(p));
#pragma unroll
        for (int j = 0; j < 8; ++j) v[j] += p[64 * j + lane]; }
}
__device__ __forceinline__ void sample_gate_row(ArgP A, int m, int lane, f32x4 (&v)[8]) {
    part_sum(A->ws, m, 8, lane, v);
    const GAS f32x4* xf = (const GAS f32x4*)(A->ws + WS_XF) + (size_t)m * (DM / 4); const GAS f32x4* pl = (const GAS f32x4*)(A->ws + WS_PLE) + (size_t)m * (DM / 4);
#pragma unroll
    for (int j = 0; j < 8; ++j) { const f32x4 x = xf[64 * j + lane], q = pl[64 * j + lane]; f32x4 o;
#pragma unroll
        for (int e = 0; e < 4; ++e) o[e] = x[e] + q[e] * sigm(v[j][e]);
        v[j] = o; }
}
__device__ __forceinline__ void final_phase(ArgP A, int lane, int wave, int bid, int G) {
    for (int m = MP + bid * NWAVES + wave; m < MT; m += G * NWAVES) { f32x4 v[8]; sample_gate_row(A, m, lane, v); GAS f32x4* o = (GAS f32x4*)(A->out + O_Y) + (size_t)m * (DM / 4);
#pragma unroll
        for (int j = 0; j < 8; ++j) o[64 * j + lane] = v[j]; }
}
__device__ __forceinline__ int row_of(int gw, int NW, int i) {
    if (NW != 2048) { const int m = gw + i * NW; return m < MT ? m : -1; }
    if (gw < MS) return i == 0 ? MP + gw : (i == 1 ? gw : -1);
    return i < 5 ? MS + (gw - MS) + 1536 * i : -1;
}
__device__ __forceinline__ void rowA_phase(ArgP A, int layer, int lane, int wave, int bid, int G) {
    const int gw_ = bid * NWAVES + wave, NW_ = G * NWAVES;
    for (int ri = 0, m = row_of(gw_, NW_, 0); m >= 0; m = row_of(gw_, NW_, ++ri)) {
        if (m >= MP) { f32x4 v[8]; sample_gate_row(A, m, lane, v); GAS f32x4* o = (GAS f32x4*)(A->out + O_Y) + (size_t)m * (DM / 4); float s = 0.f;
#pragma unroll
            for (int j = 0; j < 8; ++j) { o[64 * j + lane] = v[j]; s += (v[j].x * v[j].x + v[j].y * v[j].y) + (v[j].z * v[j].z + v[j].w * v[j].w); }
            const float r = rsqrtf(wave_sum(s) * (1.0f / DM) + 1e-6f); const GAS float* g = A->in[8] + layer * DM; GAS u32x2* xn = (GAS u32x2*)(A->ws + WS_XN) + (size_t)m * (DM / 4);
#pragma unroll
            for (int j = 0; j < 8; ++j) { const f32x4 gg = ((const GAS f32x4*)g)[64 * j + lane]; u32x2 w; w.x = pk2(v[j].x * r * gg.x, v[j].y * r * gg.y); w.y = pk2(v[j].z * r * gg.z, v[j].w * r * gg.w); xn[64 * j + lane] = w; }
        } else row_rms_bf16(xrow(A, layer, m), A->in[8] + layer * DM, (GAS bf16*)(A->ws + WS_XN) + (size_t)m * DM, lane);
    }
}
__device__ __forceinline__ void rowB_phase(ArgP A, int layer, int lane, int wave, int bid, int G) {
    const GAS float* gpost = A->in[9] + layer * DM; const GAS float* gpre = A->in[10] + layer * DM;
    const int gw_ = bid * NWAVES + wave, NW_ = G * NWAVES; int ri = 0; int m = row_of(gw_, NW_, 0);
    f32x4 xv[8], mv[8];
#define ROWB_LOAD(mm, X, M_) do { const GAS f32x4* x_ = (const GAS f32x4*)xrow(A, layer, (mm)); const GAS f32x4* mx_ = (const GAS f32x4*)(A->ws + WS_MIX) + (size_t)(mm) * (DM / 4); \
        _Pragma("unroll") for (int j = 0; j < 8; ++j) { X[j] = __builtin_nontemporal_load(&x_[64 * j + lane]); if ((mm) < MP) M_[j] = __builtin_nontemporal_load(&mx_[64 * j + lane]); } } while (0)
    if (m >= 0) ROWB_LOAD(m, xv, mv);
    while (m >= 0) {
        const int mn = row_of(gw_, NW_, ++ri); f32x4 xn2[8], mn2[8];
        if (mn >= 0) ROWB_LOAD(mn, xn2, mn2);
        if (m >= MP) part_sum(A->ws, m, 8, lane, mv);
        float s = 0.f;
#pragma unroll
        for (int j = 0; j < 8; ++j) s += (mv[j].x * mv[j].x + mv[j].y * mv[j].y) + (mv[j].z * mv[j].z + mv[j].w * mv[j].w);
        const float r1 = rsqrtf(wave_sum(s) * (1.0f / DM) + 1e-6f); float s2 = 0.f;
#pragma unroll
        for (int j = 0; j < 8; ++j) { const f32x4 g = ((const GAS f32x4*)gpost)[64 * j + lane]; xv[j] = xv[j] + mv[j] * r1 * g; s2 += (xv[j].x * xv[j].x + xv[j].y * xv[j].y) + (xv[j].z * xv[j].z + xv[j].w * xv[j].w); }
        const float r2 = rsqrtf(wave_sum(s2) * (1.0f / DM) + 1e-6f);
        GAS f32x4* xf = (GAS f32x4*)(A->ws + WS_XF) + (size_t)m * (DM / 4); GAS u32x2* xn = (GAS u32x2*)(A->ws + WS_XN) + (size_t)m * (DM / 4);
#pragma unroll
        for (int j = 0; j < 8; ++j) { const f32x4 g = ((const GAS f32x4*)gpre)[64 * j + lane]; xf[64 * j + lane] = xv[j];
            u32x2 w; w.x = pk2(xv[j].x * r2 * g.x, xv[j].y * r2 * g.y); w.y = pk2(xv[j].z * r2 * g.z, xv[j].w * r2 * g.w); xn[64 * j + lane] = w; }
#pragma unroll
        for (int j = 0; j < 8; ++j) { xv[j] = xn2[j]; mv[j] = mn2[j]; }
        m = mn;
    }
#undef ROWB_LOAD
}
__device__ __forceinline__ void rowC_phase(ArgP A, int layer, int lane, int wave, int bid, int G) {
    const GAS float* gpost = A->in[11] + layer * DM;
    const int gw_ = bid * NWAVES + wave, NW_ = G * NWAVES; int ri = 0; int m = row_of(gw_, NW_, 0);
    f32x4 xv[8], mv[8];
#define ROWC_LOAD(mm, X, M_) do { const GAS f32x4* x_ = (const GAS f32x4*)(A->ws + WS_XF) + (size_t)(mm) * (DM / 4); const GAS f32x4* mx_ = (const GAS f32x4*)(A->ws + WS_MIX) + (size_t)(mm) * (DM / 4); \
        _Pragma("unroll") for (int j = 0; j < 8; ++j) { X[j] = __builtin_nontemporal_load(&x_[64 * j + lane]); if ((mm) < MP) M_[j] = __builtin_nontemporal_load(&mx_[64 * j + lane]); } } while (0)
    if (m >= 0) ROWC_LOAD(m, xv, mv);
    while (m >= 0) {
        const int mn = row_of(gw_, NW_, ++ri); f32x4 xn2[8], mn2[8];
        if (mn >= 0) ROWC_LOAD(mn, xn2, mn2);
        if (m >= MP) part_sum(A->ws, m, 11, lane, mv);
        float s = 0.f;
#pragma unroll
        for (int j = 0; j < 8; ++j) s += (mv[j].x * mv[j].x + mv[j].y * mv[j].y) + (mv[j].z * mv[j].z + mv[j].w * mv[j].w);
        const float r1 = rsqrtf(wave_sum(s) * (1.0f / DM) + 1e-6f);
        GAS f32x4* xf = (GAS f32x4*)(A->ws + WS_XF) + (size_t)m * (DM / 4); GAS u32x2* xn = (GAS u32x2*)(A->ws + WS_XN) + (size_t)m * (DM / 4);
#pragma unroll
        for (int j = 0; j < 8; ++j) { const f32x4 g = ((const GAS f32x4*)gpost)[64 * j + lane]; const f32x4 o = xv[j] + mv[j] * r1 * g; xf[64 * j + lane] = o;
            u32x2 w; w.x = pk2(o.x, o.y); w.y = pk2(o.z, o.w); xn[64 * j + lane] = w; }
#pragma unroll
        for (int j = 0; j < 8; ++j) { xv[j] = xn2[j]; mv[j] = mn2[j]; }
        m = mn;
    }
#undef ROWC_LOAD
}
__device__ __forceinline__ void m1_phase(ArgP A, int layer, LAS unsigned char* lds, int tid, int lane, int wave, int bid, int G) {
    const GAS float* Z = (const GAS float*)(A->ws + WS_A);
    GAS float* RW = (GAS float*)(A->ws + WS_B); GAS float* RK = RW + 7 * SZ;
    GAS float* U = (GAS float*)(A->ws + WS_C) + SZ; GAS float* VLN = U + SZ;
    const GAS float* mu = A->in[13] + layer * RC; const GAS float* wl = A->in[14] + layer * 32 * 512; const GAS float* w0 = A->in[15] + layer * 512;
    const GAS float* al = A->in[16] + layer * 32 * 512; const GAS float* a0 = A->in[17] + layer * 512; const GAS float* gl = A->in[18] + layer * 96 * 512;
    const GAS float* kk_ = A->in[19] + layer * 512; const GAS float* ka_ = A->in[20] + layer * 512; const GAS float* rk_ = A->in[21] + layer * 512;
    const GAS float* lnw = A->in[24] + layer * 512; const GAS float* lnb = A->in[25] + layer * 512;
    const GAS float* shift_st = A->in[3] + (size_t)layer * 128 * RC;
    const int c = lane & 15, quad = lane >> 4, h = wave;
    LAS float* part = (LAS float*)(lds + 131072);
    LAS unsigned char* fr = lds + wave * 16384 + lane * 16;
    bf16x8 bw[4];
#pragma unroll
    for (int ct = 0; ct < 4; ++ct) { const int n = h * 64 + ct * 16 + c; float tb[8];
#pragma unroll
        for (int j = 0; j < 8; ++j) tb[j] = wl[(quad * 8 + j) * 512 + n];
        bw[ct] = pack8(tb);
#pragma unroll
        for (int j = 0; j < 8; ++j) tb[j] = al[(quad * 8 + j) * 512 + n];
        *(LAS bf16x8*)(fr + ct * 1024) = pack8(tb);
#pragma unroll
        for (int kk = 0; kk < 3; ++kk) {
#pragma unroll
            for (int j = 0; j < 8; ++j) tb[j] = gl[(kk * 32 + quad * 8 + j) * 512 + n];
            *(LAS bf16x8*)(fr + (4 + kk * 4 + ct) * 1024) = pack8(tb); } }
    LDS_WAIT();
    float p_mr[4], p_mk[4], p_mv[4], p_w0[4], p_a0[4], p_kk[4], p_ka[4], p_rk[4], p_lw[4], p_lb[4];
#pragma unroll
    for (int ct = 0; ct < 4; ++ct) { const int n = h * 64 + ct * 16 + c; p_mr[ct] = mu[n]; p_mk[ct] = mu[512 + n]; p_mv[ct] = mu[1024 + n]; p_w0[ct] = w0[n]; p_a0[ct] = a0[n];
        p_kk[ct] = kk_[n]; p_ka[ct] = ka_[n]; p_rk[ct] = rk_[n]; p_lw[ct] = lnw[n]; p_lb[ct] = lnb[n]; }
    for (int unit = bid; unit < 512 + 64; unit += G) {
        const int tile = unit < 512 ? unit : 512 + ((unit - 512) >> 1); const int jlo = unit < 512 ? 0 : ((unit - 512) & 1) * 2, jhi = unit < 512 ? 4 : jlo + 2;
        const int m0 = tile * 16;
        f32x4 accw[4], acca[4], accg[4];
        {
            const int m = m0 + c; float msk; const GAS float* zr = Z + (size_t)m * NCP; const GAS float* pr = prev_row(Z, shift_st, m, msk);
            float t[8]; bf16x8 aw, aa, ag[3];
            zm8(zr, pr, msk, mu, 1536 + quad * 8, t);
#pragma unroll
            for (int j = 0; j < 8; ++j) t[j] = tanhf(t[j]);
            aw = pack8(t);
            zm8(zr, pr, msk, mu, 1568 + quad * 8, t); aa = pack8(t);
#pragma unroll
            for (int kk = 0; kk < 3; ++kk) { zm8(zr, pr, msk, mu, 1600 + kk * 32 + quad * 8, t);
#pragma unroll
                for (int j = 0; j < 8; ++j) t[j] = sigm(t[j]);
                ag[kk] = pack8(t); }
            const f32x4 zero = {0.f, 0.f, 0.f, 0.f};
#pragma unroll
            for (int ct = 0; ct < 4; ++ct) {
                accw[ct] = __builtin_amdgcn_mfma_f32_16x16x32_bf16(aw, bw[ct], zero, 0, 0, 0);
                acca[ct] = __builtin_amdgcn_mfma_f32_16x16x32_bf16(aa, *(const LAS bf16x8*)(fr + ct * 1024), zero, 0, 0, 0);
                accg[ct] = zero;
#pragma unroll
                for (int kk = 0; kk < 3; ++kk) accg[ct] = __builtin_amdgcn_mfma_f32_16x16x32_bf16(ag[kk], *(const LAS bf16x8*)(fr + (4 + kk * 4 + ct) * 1024), accg[ct], 0, 0, 0); }
        }
        float vg[4][4];
#pragma unroll
        for (int jj = 0; jj < 4; ++jj) {
            if (jj < jlo || jj >= jhi) continue;
            const int m = m0 + quad * 4 + jj; float msk; const GAS float* zr = Z + (size_t)m * NCP; const GAS float* pr = prev_row(Z, shift_st, m, msk);
            float r_[4], km[4], v_[4], wd[4], as[4], kkv[4]; float nsq = 0.f, rks = 0.f, s1 = 0.f, s2 = 0.f;
            float i_r[4], i_k[4], i_v[4], i_pr[4], i_pk[4], i_pv[4], i_su[4], i_sv[4];
#pragma unroll
            for (int ct = 0; ct < 4; ++ct) { const int n = h * 64 + ct * 16 + c; i_r[ct] = zr[n]; i_k[ct] = zr[512 + n]; i_v[ct] = zr[1024 + n]; i_pr[ct] = pr[n]; i_pk[ct] = pr[512 + n]; i_pv[ct] = pr[1024 + n];
                i_su[ct] = zr[C_S + n]; i_sv[ct] = zr[C_S + 512 + n]; }
            float gu[4];
#pragma unroll
            for (int ct = 0; ct < 4; ++ct) {
                const float zr_r = i_r[ct], zr_k = i_k[ct], zr_v = i_v[ct];
                r_[ct] = zr_r + p_mr[ct] * (i_pr[ct] * msk - zr_r);
                const float kraw = zr_k + p_mk[ct] * (i_pk[ct] * msk - zr_k);
                v_[ct] = zr_v + p_mv[ct] * (i_pv[ct] * msk - zr_v);
                wd[ct] = __expf(-0.6065306597f * sigm(p_w0[ct] + accw[ct][jj]));
                as[ct] = sigm(p_a0[ct] + acca[ct][jj]);
                kkv[ct] = kraw * p_kk[ct]; km[ct] = kraw * (1.0f + (as[ct] - 1.0f) * p_ka[ct]);
                nsq += kkv[ct] * kkv[ct]; rks += r_[ct] * km[ct] * p_rk[ct];
                gu[ct] = gelu_erf(i_su[ct]);
                const float gv = gelu_erf(i_sv[ct]); vg[jj][ct] = gv; s1 += gv; s2 += gv * gv; }
#pragma unroll
            for (int ct = 0; ct < 4; ++ct) U[(size_t)m * 512 + h * 64 + ct * 16 + c] = gu[ct];
            nsq = red16(nsq); rks = red16(rks); s1 = red16(s1); s2 = red16(s2);
            const float inv = 1.0f / fmaxf(sqrtf(nsq), 1e-12f);
#pragma unroll
            for (int ct = 0; ct < 4; ++ct) { const size_t o = (size_t)m * 512 + h * 64 + ct * 16 + c; const float kn = kkv[ct] * inv;
                RW[o] = r_[ct]; RW[SZ + o] = wd[ct]; RW[2 * SZ + o] = km[ct]; RW[3 * SZ + o] = v_[ct]; RW[4 * SZ + o] = -kn; RW[5 * SZ + o] = kn * as[ct]; RW[6 * SZ + o] = accg[ct][jj]; }
            if (c == 0) { RK[m * 8 + h] = rks; part[(wave * 16 + quad * 4 + jj) * 2] = s1; part[(wave * 16 + quad * 4 + jj) * 2 + 1] = s2; }
        }
        __syncthreads();
#pragma unroll
        for (int jj = 0; jj < 4; ++jj) {
            if (jj < jlo || jj >= jhi) continue;
            const int tk = quad * 4 + jj, m = m0 + tk; float S1 = 0.f, S2 = 0.f;
#pragma unroll
            for (int w = 0; w < 8; ++w) { S1 += part[(w * 16 + tk) * 2]; S2 += part[(w * 16 + tk) * 2 + 1]; }
            const float mean = S1 * (1.0f / 512.0f), var = fmaxf(S2 * (1.0f / 512.0f) - mean * mean, 0.f), rstd = rsqrtf(var + 1e-5f);
#pragma unroll
            for (int ct = 0; ct < 4; ++ct) { const int n = h * 64 + ct * 16 + c; const float vl = (vg[jj][ct] - mean) * rstd * p_lw[ct] + p_lb[ct];
                VLN[(size_t)m * 512 + n] = vl; if (m >= MP) A->out[O_SGV + ((size_t)layer * MS + (m - MP)) * 512 + n] = vl; }
        }
#pragma unroll
        for (int tk = 3; tk < 16; tk += 4) { const int m = m0 + tk;
            const bool last = (jhi < 4) ? false : (m < MP) ? ((m & (SEQ - 1)) == SEQ - 1) : (((m - MP) & 3) == 3);
            if (last) { GAS float* dst = (m < MP) ? A->out + O_SH_P + ((size_t)layer * 4 + (m >> 11)) * RC : A->out + O_SH_S + ((size_t)layer * 128 + ((m - MP) >> 2)) * RC;
                for (int cc = tid; cc < RC; cc += NTHR) dst[cc] = Z[(size_t)m * NCP + cc]; } }
        __syncthreads();
    }
}

__device__ __forceinline__ void rwkv_scan_rg(LAS float* buf, const GAS float* RW, int mbase, int nsteps, int h, int rg, const GAS float* Sinit, GAS float* Sout, GAS float* YR, int lane) {
    const int rl = lane >> 3, cgp = lane & 7;
    float S[8];
    if (Sinit) { const f32x4 s0 = *(const GAS f32x4*)(Sinit + (rg * 8 + rl) * 64 + cgp * 8), s1 = *(const GAS f32x4*)(Sinit + (rg * 8 + rl) * 64 + cgp * 8 + 4);
        S[0] = s0.x; S[1] = s0.y; S[2] = s0.z; S[3] = s0.w; S[4] = s1.x; S[5] = s1.y; S[6] = s1.z; S[7] = s1.w; }
    else {
#pragma unroll
        for (int i = 0; i < 8; ++i) S[i] = 0.f; }
    const GAS float* gp = RW + (size_t)mbase * 512 + h * 64 + lane;
    float pre[24];
#pragma unroll
    for (int s = 0; s < 4; ++s)
#pragma unroll
        for (int q = 0; q < 6; ++q) pre[s * 6 + q] = gp[(size_t)q * SZ + s * 512];
#pragma unroll
    for (int i = 0; i < 24; ++i) buf[i * 64 + lane] = pre[i];
    const int nch = nsteps >> 2;
    for (int ci = 0; ci < nch; ++ci) {
        const bool more = ci + 1 < nch;
        if (more) { const GAS float* g2 = gp + (size_t)(ci + 1) * 4 * 512;
#pragma unroll
            for (int s = 0; s < 4; ++s)
#pragma unroll
                for (int q = 0; q < 6; ++q) pre[s * 6 + q] = g2[(size_t)q * SZ + s * 512]; }
        LDS_WAIT();
        const LAS float* cb = buf + (ci & 1) * 1536;
#pragma unroll
        for (int s = 0; s < 4; ++s) { const LAS float* sb = cb + s * 384;
            const f32x4 r0 = *(const LAS f32x4*)(sb + cgp * 8), r1 = *(const LAS f32x4*)(sb + cgp * 8 + 4);
            const f32x4 w0 = *(const LAS f32x4*)(sb + 64 + cgp * 8), w1 = *(const LAS f32x4*)(sb + 64 + cgp * 8 + 4);
            const f32x4 k0 = *(const LAS f32x4*)(sb + 128 + cgp * 8), k1 = *(const LAS f32x4*)(sb + 128 + cgp * 8 + 4);
            const f32x4 a0 = *(const LAS f32x4*)(sb + 256 + cgp * 8), a1 = *(const LAS f32x4*)(sb + 256 + cgp * 8 + 4);
            const f32x4 b0 = *(const LAS f32x4*)(sb + 320 + cgp * 8), b1 = *(const LAS f32x4*)(sb + 320 + cgp * 8 + 4);
            const float vv = sb[192 + rg * 8 + rl];
            const float rr[8] = {r0.x, r0.y, r0.z, r0.w, r1.x, r1.y, r1.z, r1.w}, ww[8] = {w0.x, w0.y, w0.z, w0.w, w1.x, w1.y, w1.z, w1.w}, kx[8] = {k0.x, k0.y, k0.z, k0.w, k1.x, k1.y, k1.z, k1.w};
            const float ax[8] = {a0.x, a0.y, a0.z, a0.w, a1.x, a1.y, a1.z, a1.w}, bx[8] = {b0.x, b0.y, b0.z, b0.w, b1.x, b1.y, b1.z, b1.w};
            float sa = 0.f;
#pragma unroll
            for (int i = 0; i < 8; ++i) sa += S[i] * ax[i];
            sa = red8(sa);
            float y = 0.f;
#pragma unroll
            for (int i = 0; i < 8; ++i) { S[i] = S[i] * ww[i] + (sa * bx[i] + vv * kx[i]); y += S[i] * rr[i]; }
            y = red8(y);
            if (cgp == 0) YR[(size_t)(mbase + ci * 4 + s) * 512 + h * 64 + rg * 8 + rl] = y;
        }
        if (more) { LAS float* nb = buf + ((ci + 1) & 1) * 1536;
#pragma unroll
            for (int i = 0; i < 24; ++i) nb[i * 64 + lane] = pre[i]; }
    }
    GAS float* so = Sout + (rg * 8 + rl) * 64 + cgp * 8;
    *(GAS f32x4*)so = (f32x4){S[0], S[1], S[2], S[3]}; *(GAS f32x4*)(so + 4) = (f32x4){S[4], S[5], S[6], S[7]};
}
__device__ __forceinline__ void rwkv_sample_wave(LAS float* buf, const GAS float* RW, int mbase, int h, const GAS float* Sinit, GAS float* Sout, GAS float* YR, int lane) {
    const int rl = lane >> 3, cgp = lane & 7;
    const GAS float* gp = RW + (size_t)mbase * 512 + h * 64 + lane;
    float pre[24];
#pragma unroll
    for (int s = 0; s < 4; ++s)
#pragma unroll
        for (int q = 0; q < 6; ++q) pre[s * 6 + q] = gp[(size_t)q * SZ + s * 512];
    f32x4 n0 = __builtin_nontemporal_load((const GAS f32x4*)(Sinit + rl * 64 + cgp * 8)), n1 = __builtin_nontemporal_load((const GAS f32x4*)(Sinit + rl * 64 + cgp * 8 + 4));
#pragma unroll
    for (int i = 0; i < 24; ++i) buf[i * 64 + lane] = pre[i];
    LDS_WAIT();
    for (int rg = 0; rg < 8; ++rg) {
        float S[8] = {n0.x, n0.y, n0.z, n0.w, n1.x, n1.y, n1.z, n1.w};
        if (rg + 1 < 8) { n0 = __builtin_nontemporal_load((const GAS f32x4*)(Sinit + ((rg + 1) * 8 + rl) * 64 + cgp * 8)); n1 = __builtin_nontemporal_load((const GAS f32x4*)(Sinit + ((rg + 1) * 8 + rl) * 64 + cgp * 8 + 4)); }
#pragma unroll
        for (int s = 0; s < 4; ++s) { const LAS float* sb = buf + s * 384;
            const f32x4 r0 = *(const LAS f32x4*)(sb + cgp * 8), r1 = *(const LAS f32x4*)(sb + cgp * 8 + 4), w0 = *(const LAS f32x4*)(sb + 64 + cgp * 8), w1 = *(const LAS f32x4*)(sb + 64 + cgp * 8 + 4);
            const f32x4 k0 = *(const LAS f32x4*)(sb + 128 + cgp * 8), k1 = *(const LAS f32x4*)(sb + 128 + cgp * 8 + 4), a0 = *(const LAS f32x4*)(sb + 256 + cgp * 8), a1 = *(const LAS f32x4*)(sb + 256 + cgp * 8 + 4);
            const f32x4 b0 = *(const LAS f32x4*)(sb + 320 + cgp * 8), b1 = *(const LAS f32x4*)(sb + 320 + cgp * 8 + 4);
            const float vv = sb[192 + rg * 8 + rl];
            const float rr[8] = {r0.x, r0.y, r0.z, r0.w, r1.x, r1.y, r1.z, r1.w}, ww[8] = {w0.x, w0.y, w0.z, w0.w, w1.x, w1.y, w1.z, w1.w}, kx[8] = {k0.x, k0.y, k0.z, k0.w, k1.x, k1.y, k1.z, k1.w};
            const float ax[8] = {a0.x, a0.y, a0.z, a0.w, a1.x, a1.y, a1.z, a1.w}, bx[8] = {b0.x, b0.y, b0.z, b0.w, b1.x, b1.y, b1.z, b1.w};
            float sa = 0.f;
#pragma unroll
            for (int i = 0; i < 8; ++i) sa += S[i] * ax[i];
            sa = red8(sa);
            float y = 0.f;
#pragma unroll
            for (int i = 0; i < 8; ++i) { S[i] = S[i] * ww[i] + (sa * bx[i] + vv * kx[i]); y += S[i] * rr[i]; }
            y = red8(y);
            if (cgp == 0) YR[(size_t)(mbase + s) * 512 + h * 64 + rg * 8 + rl] = y; }
        GAS float* so = Sout + (rg * 8 + rl) * 64 + cgp * 8;
        __builtin_nontemporal_store((f32x4){S[0], S[1], S[2], S[3]}, (GAS f32x4*)so); __builtin_nontemporal_store((f32x4){S[4], S[5], S[6], S[7]}, (GAS f32x4*)(so + 4));
    }
    LDS_WAIT();
}
__device__ __forceinline__ float hgrn_lb(const GAS float* logits, int layer, int cfull) {
    if (layer == 0) return 0.f;
    return 1.0f / (1.0f + __expf(logits[cfull] - logits[512 + cfull]));
}
__device__ __forceinline__ void hgrn_prompt_job(LAS unsigned char* lds, const GAS float* Z, const GAS float* logits, int layer, int b, int h, int dq, GAS float* OP, GAS float* Sout, int tid, int lane, int wave) {
    LAS float* OPS = (LAS float*)lds;
    LAS float* VV = (LAS float*)(lds + 12288);
    LAS float* OPL = (LAS float*)(lds + 28672);
    const int st = tid >> 5, sd = tid & 31, cfull = h * 128 + dq * 32 + sd;
    const float lb = hgrn_lb(logits, layer, cfull);
    const int mbase = b * SEQ;
    const GAS float* zq = Z + (size_t)mbase * NCP + C_H + cfull; const GAS float* zf = zq + 512; const GAS float* zv = Z + (size_t)mbase * NCP + C_H + 1024 + h * 128;
    const int slot = (st * 4 + (sd >> 3)) * 24 + (sd & 7);
    {   const float f = zf[(size_t)st * NCP], q = zq[(size_t)st * NCP], fg = lb + (1.0f - lb) * sigm(f);
        OPS[slot] = fg; OPS[slot + 8] = 1.0f - fg; OPS[slot + 16] = q * sigm(q);
#pragma unroll
        for (int i = 0; i < 4; ++i) { const int idx = tid + 512 * i; VV[idx] = zv[(size_t)(idx >> 7) * NCP + (idx & 127)]; } }
    __syncthreads();
    float S[8][2];
#pragma unroll
    for (int d = 0; d < 8; ++d) { S[d][0] = 0.f; S[d][1] = 0.f; }
    for (int ci = 0; ci < SEQ / 16; ++ci) {
        const bool more = ci + 1 < SEQ / 16; float pf = 0.f, pq = 0.f, pv[4] = {0.f, 0.f, 0.f, 0.f};
        if (more) { const size_t row = (size_t)(ci + 1) * 16; pf = zf[(row + st) * NCP]; pq = zq[(row + st) * NCP];
#pragma unroll
            for (int i = 0; i < 4; ++i) { const int idx = tid + 512 * i; pv[i] = zv[(row + (idx >> 7)) * NCP + (idx & 127)]; } }
        if (wave < 4) {
            const LAS float* co = OPS + (ci & 1) * 1536; const LAS float* cv = VV + (ci & 1) * 2048;
#pragma unroll 4
            for (int t = 0; t < 16; ++t) { const LAS float* ob = co + (t * 4 + wave) * 24;
                const f32x4 F0 = *(const LAS f32x4*)ob, F1 = *(const LAS f32x4*)(ob + 4), K0 = *(const LAS f32x4*)(ob + 8), K1 = *(const LAS f32x4*)(ob + 12), Q0 = *(const LAS f32x4*)(ob + 16), Q1 = *(const LAS f32x4*)(ob + 20);
                const float Fx[8] = {F0.x, F0.y, F0.z, F0.w, F1.x, F1.y, F1.z, F1.w}, Kx[8] = {K0.x, K0.y, K0.z, K0.w, K1.x, K1.y, K1.z, K1.w}, Qx[8] = {Q0.x, Q0.y, Q0.z, Q0.w, Q1.x, Q1.y, Q1.z, Q1.w};
                const float v0 = cv[t * 128 + lane], v1 = cv[t * 128 + 64 + lane]; float o0 = 0.f, o1 = 0.f;
#pragma unroll
                for (int d = 0; d < 8; ++d) { S[d][0] = Fx[d] * S[d][0] + Kx[d] * v0; S[d][1] = Fx[d] * S[d][1] + Kx[d] * v1; o0 += Qx[d] * S[d][0]; o1 += Qx[d] * S[d][1]; }
                OPL[(t * 4 + wave) * 128 + lane] = o0; OPL[(t * 4 + wave) * 128 + 64 + lane] = o1; }
        }
        if (more) { LAS float* no = OPS + ((ci + 1) & 1) * 1536; LAS float* nv = VV + ((ci + 1) & 1) * 2048;
            const float fg = lb + (1.0f - lb) * sigm(pf); no[slot] = fg; no[slot + 8] = 1.0f - fg; no[slot + 16] = pq * sigm(pq);
#pragma unroll
            for (int i = 0; i < 4; ++i) nv[tid + 512 * i] = pv[i]; }
        __syncthreads();
#pragma unroll
        for (int i = 0; i < 4; ++i) { const int idx = tid + 512 * i, t = idx >> 7, v = idx & 127;
            const float s = (OPL[(t * 4 + 0) * 128 + v] + OPL[(t * 4 + 1) * 128 + v]) + (OPL[(t * 4 + 2) * 128 + v] + OPL[(t * 4 + 3) * 128 + v]);
            OP[(size_t)dq * SZ + (size_t)(mbase + ci * 16 + t) * 512 + h * 128 + v] = s; }
        __syncthreads();
    }
    if (wave < 4) {
#pragma unroll
        for (int d = 0; d < 8; ++d) { Sout[(dq * 32 + wave * 8 + d) * 128 + lane] = S[d][0]; Sout[(dq * 32 + wave * 8 + d) * 128 + 64 + lane] = S[d][1]; } }
}
__device__ __forceinline__ void hgrn_sample_wave(LAS float* buf, const GAS float* Z, const GAS float* logits, int layer, int b, int h, int vh, const GAS float* Sin, GAS float* Sout, GAS bf16* OPB, int lane) {
    const int mbase = MP + b * 4;
#pragma unroll
    for (int t = 0; t < 4; ++t)
#pragma unroll
        for (int dd = 0; dd < 2; ++dd) { const int d = lane + 64 * dd, cfull = h * 128 + d; const float lb = hgrn_lb(logits, layer, cfull);
            const float q = Z[(size_t)(mbase + t) * NCP + C_H + cfull], f = Z[(size_t)(mbase + t) * NCP + C_H + 512 + cfull], fg = lb + (1.0f - lb) * sigm(f);
            *(LAS f32x4*)(buf + (t * 128 + d) * 4) = (f32x4){fg, 1.0f - fg, q * sigm(q), 0.f}; }
    float vt[4], o[4];
#pragma unroll
    for (int t = 0; t < 4; ++t) { vt[t] = Z[(size_t)(mbase + t) * NCP + C_H + 1024 + h * 128 + vh * 64 + lane]; o[t] = 0.f; }
    LDS_WAIT();
    float Sn[8];
#pragma unroll
    for (int dd = 0; dd < 8; ++dd) Sn[dd] = __builtin_nontemporal_load(&Sin[dd * 128 + vh * 64 + lane]);
    for (int dc = 0; dc < 16; ++dc) { float S[8];
#pragma unroll
        for (int dd = 0; dd < 8; ++dd) S[dd] = Sn[dd];
        if (dc + 1 < 16) {
#pragma unroll
            for (int dd = 0; dd < 8; ++dd) Sn[dd] = __builtin_nontemporal_load(&Sin[((dc + 1) * 8 + dd) * 128 + vh * 64 + lane]); }
#pragma unroll
        for (int t = 0; t < 4; ++t)
#pragma unroll
            for (int dd = 0; dd < 8; ++dd) { const f32x4 op = *(const LAS f32x4*)(buf + (t * 128 + dc * 8 + dd) * 4); S[dd] = op.x * S[dd] + op.y * vt[t]; o[t] += op.z * S[dd]; }
#pragma unroll
        for (int dd = 0; dd < 8; ++dd) __builtin_nontemporal_store(S[dd], &Sout[(dc * 8 + dd) * 128 + vh * 64 + lane]); }
#pragma unroll
    for (int t = 0; t < 4; ++t) { const size_t oi = (size_t)(mbase + t) * 512 + h * 128 + vh * 64 + lane; const unsigned hi = pk2(o[t], 0.f) & 0xffffu; const float hf = __builtin_bit_cast(float, hi << 16);
        OPB[oi] = (bf16)hi; OPB[SZ + oi] = bf1(o[t] - hf); }
    LDS_WAIT();
}
__device__ __forceinline__ void sgu_job(LAS unsigned char* lds, const GAS float* Wh, const GAS float* sbias, const GAS float* VLN, GAS float* U, int m0, int h, int tid) {
    LAS float* WL = (LAS float*)lds;
    LAS float* VT = (LAS float*)(lds + 67584);
#pragma unroll 2
    for (int i0 = 0; i0 < 32; i0 += 16) { float tw[16], tv[16];
#pragma unroll
        for (int i = 0; i < 16; ++i) { const int idx = tid + 512 * (i0 + i), t = idx >> 7, s = idx & 127; tw[i] = Wh[idx]; tv[i] = VLN[(size_t)(m0 + t) * 512 + h * 128 + s]; }
#pragma unroll
        for (int i = 0; i < 16; ++i) { const int idx = tid + 512 * (i0 + i), t = idx >> 7, s = idx & 127; WL[t * 132 + s] = (s <= t) ? tw[i] : 0.f; VT[idx] = tv[i]; } }
    __syncthreads();
    const int t0 = (tid >> 4) * 4, d0 = (tid & 15) * 8;
    float acc[4][8];
#pragma unroll
    for (int i = 0; i < 4; ++i)
#pragma unroll
        for (int j = 0; j < 8; ++j) acc[i][j] = 0.f;
    for (int s = 0; s <= t0 + 3; ++s) {
        const f32x4 v0 = *(const LAS f32x4*)(VT + s * 128 + d0), v1 = *(const LAS f32x4*)(VT + s * 128 + d0 + 4);
#pragma unroll
        for (int i = 0; i < 4; ++i) { const float w = WL[(t0 + i) * 132 + s];
            acc[i][0] += w * v0.x; acc[i][1] += w * v0.y; acc[i][2] += w * v0.z; acc[i][3] += w * v0.w; acc[i][4] += w * v1.x; acc[i][5] += w * v1.y; acc[i][6] += w * v1.z; acc[i][7] += w * v1.w; }
    }
#pragma unroll
    for (int i = 0; i < 4; ++i) { const int t = t0 + i; const float bias = sbias[t]; GAS float* up = U + (size_t)(m0 + t) * 512 + h * 128 + d0;
        f32x4 u0 = *(const GAS f32x4*)up, u1 = *(const GAS f32x4*)(up + 4);
        u0.x *= acc[i][0] + bias; u0.y *= acc[i][1] + bias; u0.z *= acc[i][2] + bias; u0.w *= acc[i][3] + bias; u1.x *= acc[i][4] + bias; u1.y *= acc[i][5] + bias; u1.z *= acc[i][6] + bias; u1.w *= acc[i][7] + bias;
        *(GAS f32x4*)up = u0; *(GAS f32x4*)(up + 4) = u1; }
    __syncthreads();
}
typedef float f32x2 __attribute__((ext_vector_type(2)));
constexpr int RW_D = 8, RW_NS = 9;
__device__ __forceinline__ void rwkv_prompt_wave(LAS float* ring, const GAS float* RW, int mbase, int h, int rg, GAS float* Sout, GAS float* YR, int lane) {
    const int rl = lane >> 3, cgp = lane & 7;
    f32x2 S[4];
#pragma unroll
    for (int i = 0; i < 4; ++i) S[i] = (f32x2){0.f, 0.f};
    unsigned off[6];
#pragma unroll
    for (int i = 0; i < 6; ++i) { const int e = i * 256 + lane * 4, st = e / 384, rem = e - st * 384; off[i] = (unsigned)((rem >> 6) * SZ + st * 512 + (rem & 63)); }
    const GAS float* gp = RW + (size_t)mbase * 512 + h * 64;
    constexpr int NCH = SEQ / 4;
#define RW_ISSUE(cc, slot) do { const GAS float* g_ = gp + (size_t)(cc) * 2048; LAS float* l_ = ring + (slot) * 1536; _Pragma("unroll") for (int i_ = 0; i_ < 6; ++i_) \
        __builtin_amdgcn_global_load_lds((const GAS unsigned*)(g_ + off[i_]), (LAS unsigned*)(l_ + i_ * 256), 16, 0, 0); } while (0)
    for (int cc = 0; cc < RW_D - 1; ++cc) RW_ISSUE(cc, cc);
    float ykeep = 0.f;
    struct RwOps { f32x4 r0, r1, w0, w1, k0, k1, a0, a1, b0, b1; float vv; };
#define RW_LOAD(o, sb_) do { const LAS float* sb = (sb_); (o).r0 = *(const LAS f32x4*)(sb + cgp * 8); (o).r1 = *(const LAS f32x4*)(sb + cgp * 8 + 4); (o).w0 = *(const LAS f32x4*)(sb + 64 + cgp * 8); (o).w1 = *(const LAS f32x4*)(sb + 64 + cgp * 8 + 4); \
        (o).k0 = *(const LAS f32x4*)(sb + 128 + cgp * 8); (o).k1 = *(const LAS f32x4*)(sb + 128 + cgp * 8 + 4); (o).a0 = *(const LAS f32x4*)(sb + 256 + cgp * 8); (o).a1 = *(const LAS f32x4*)(sb + 256 + cgp * 8 + 4); \
        (o).b0 = *(const LAS f32x4*)(sb + 320 + cgp * 8); (o).b1 = *(const LAS f32x4*)(sb + 320 + cgp * 8 + 4); (o).vv = sb[192 + rg * 8 + rl]; asm volatile("" ::: "memory"); } while (0)
#define RW_STEP(o, s_) do { \
        const f32x2 rr[4] = {{(o).r0.x, (o).r0.y}, {(o).r0.z, (o).r0.w}, {(o).r1.x, (o).r1.y}, {(o).r1.z, (o).r1.w}}, ww[4] = {{(o).w0.x, (o).w0.y}, {(o).w0.z, (o).w0.w}, {(o).w1.x, (o).w1.y}, {(o).w1.z, (o).w1.w}}; \
        const f32x2 kx[4] = {{(o).k0.x, (o).k0.y}, {(o).k0.z, (o).k0.w}, {(o).k1.x, (o).k1.y}, {(o).k1.z, (o).k1.w}}, ax[4] = {{(o).a0.x, (o).a0.y}, {(o).a0.z, (o).a0.w}, {(o).a1.x, (o).a1.y}, {(o).a1.z, (o).a1.w}}; \
        const f32x2 bx[4] = {{(o).b0.x, (o).b0.y}, {(o).b0.z, (o).b0.w}, {(o).b1.x, (o).b1.y}, {(o).b1.z, (o).b1.w}}; \
        const f32x2 p = (S[0] * ax[0] + S[1] * ax[1]) + (S[2] * ax[2] + S[3] * ax[3]); \
        const float sa = red8(p.x + p.y); const float vv = (o).vv; \
        _Pragma("unroll") for (int i = 0; i < 4; ++i) S[i] = S[i] * ww[i] + (bx[i] * sa + kx[i] * vv); \
        const f32x2 y2 = (S[0] * rr[0] + S[1] * rr[1]) + (S[2] * rr[2] + S[3] * rr[3]); \
        const float y = red8(y2.x + y2.y); if (cgp == (s_)) ykeep = y; } while (0)
    RwOps oA, oB, oC, oD;
    asm volatile("s_waitcnt vmcnt(36)" ::: "memory");
    RW_LOAD(oA, ring); RW_LOAD(oB, ring + 384);
    for (int ci = 0; ci < NCH; ++ci) {
        { const int cn = ci + RW_D - 1; const int cl = cn < NCH ? cn : NCH - 1; RW_ISSUE(cl, cn % RW_NS); }
        const LAS float* cb = ring + (ci % RW_NS) * 1536; const LAS float* nb = ring + ((ci + 1) % RW_NS) * 1536;
        RW_LOAD(oC, cb + 768);  RW_STEP(oA, 0);
        RW_LOAD(oD, cb + 1152); RW_STEP(oB, 1);
        asm volatile("s_waitcnt vmcnt(36)" ::: "memory");
        RW_LOAD(oA, nb);        RW_STEP(oC, 2);
        RW_LOAD(oB, nb + 384);  RW_STEP(oD, 3);
        if (cgp < 4) YR[(size_t)(mbase + ci * 4 + cgp) * 512 + h * 64 + rg * 8 + rl] = ykeep;
    }
#undef RW_LOAD
#undef RW_STEP
    asm volatile("s_waitcnt vmcnt(0)" ::: "memory");
#undef RW_ISSUE
    GAS float* so = Sout + (rg * 8 + rl) * 64 + cgp * 8;
    *(GAS f32x4*)so = (f32x4){S[0].x, S[0].y, S[1].x, S[1].y}; *(GAS f32x4*)(so + 4) = (f32x4){S[2].x, S[2].y, S[3].x, S[3].y};
}
constexpr int R4_NS = 5;
__device__ __forceinline__ void rwkv_prompt_wave4(LAS float* ring, const GAS float* RW, int mbase, int h, int rq, GAS float* Sout, GAS float* YR, int lane) {
    const int rl = lane >> 4, cgp = lane & 15;
    f32x2 S[2] = {{0.f, 0.f}, {0.f, 0.f}};
    unsigned off[6];
#pragma unroll
    for (int i = 0; i < 6; ++i) { const int e = i * 256 + lane * 4, st = e / 384, rem = e - st * 384; off[i] = (unsigned)((rem >> 6) * SZ + st * 512 + (rem & 63)); }
    const GAS float* gp = RW + (size_t)mbase * 512 + h * 64;
    constexpr int NCH = SEQ / 4;
#define R4_ISSUE(cc, slot) do { const GAS float* g_ = gp + (size_t)(cc) * 2048; LAS float* l_ = ring + (slot) * 1536; _Pragma("unroll") for (int i_ = 0; i_ < 6; ++i_) \
        __builtin_amdgcn_global_load_lds((const GAS unsigned*)(g_ + off[i_]), (LAS unsigned*)(l_ + i_ * 256), 16, 0, 0); } while (0)
    struct R4Ops { f32x4 r, w, k, a, b; float vv; };
#define R4_LOAD(o, sb_) do { const LAS float* sb = (sb_); (o).r = *(const LAS f32x4*)(sb + cgp * 4); (o).w = *(const LAS f32x4*)(sb + 64 + cgp * 4); (o).k = *(const LAS f32x4*)(sb + 128 + cgp * 4); \
        (o).a = *(const LAS f32x4*)(sb + 256 + cgp * 4); (o).b = *(const LAS f32x4*)(sb + 320 + cgp * 4); (o).vv = sb[192 + rq * 4 + rl]; asm volatile("" ::: "memory"); } while (0)
#define R4_STEP(o, s_) do { \
        const f32x2 a0 = {(o).a.x, (o).a.y}, a1 = {(o).a.z, (o).a.w}, w0 = {(o).w.x, (o).w.y}, w1 = {(o).w.z, (o).w.w}, k0 = {(o).k.x, (o).k.y}, k1 = {(o).k.z, (o).k.w}; \
        const f32x2 b0 = {(o).b.x, (o).b.y}, b1 = {(o).b.z, (o).b.w}, r0 = {(o).r.x, (o).r.y}, r1 = {(o).r.z, (o).r.w}; \
        const f32x2 p = S[0] * a0 + S[1] * a1; const float sa = red16(p.x + p.y); const float vv = (o).vv; \
        S[0] = S[0] * w0 + (b0 * sa + k0 * vv); S[1] = S[1] * w1 + (b1 * sa + k1 * vv); \
        const f32x2 y2 = S[0] * r0 + S[1] * r1; const float y = red16(y2.x + y2.y); if (cgp == (s_)) ykeep = y; } while (0)
    for (int cc = 0; cc < 3; ++cc) R4_ISSUE(cc, cc);
    float ykeep = 0.f;
    R4Ops oA, oB, oC, oD;
    __builtin_amdgcn_s_setprio(3);
    asm volatile("s_waitcnt vmcnt(12)" ::: "memory");
    R4_LOAD(oA, ring); R4_LOAD(oB, ring + 384);
    for (int ci = 0; ci < NCH; ++ci) {
        { const int cn = ci + 3; const int cl = cn < NCH ? cn : NCH - 1; R4_ISSUE(cl, cn % R4_NS); }
        const LAS float* cb = ring + (ci % R4_NS) * 1536; const LAS float* nb = ring + ((ci + 1) % R4_NS) * 1536;
        R4_LOAD(oC, cb + 768);  R4_STEP(oA, 0);
        R4_LOAD(oD, cb + 1152); R4_STEP(oB, 1);
        asm volatile("s_waitcnt vmcnt(12)" ::: "memory");
        R4_LOAD(oA, nb);        R4_STEP(oC, 2);
        R4_LOAD(oB, nb + 384);  R4_STEP(oD, 3);
        if (cgp < 4) YR[(size_t)(mbase + ci * 4 + cgp) * 512 + h * 64 + rq * 4 + rl] = ykeep;
    }
    asm volatile("s_waitcnt vmcnt(0)" ::: "memory");
#undef R4_ISSUE
#undef R4_LOAD
#undef R4_STEP
    __builtin_amdgcn_s_setprio(0);
    *(GAS f32x4*)(Sout + (rq * 4 + rl) * 64 + cgp * 4) = (f32x4){S[0].x, S[0].y, S[1].x, S[1].y};
}
__device__ __forceinline__ void hgrn_prompt_job3(LAS unsigned char* lds, const GAS float* Z, const GAS float* logits, int layer, int b, int h, int de, GAS bf16* OPB, GAS float* Sout, int tid, int lane, int wave) {
    LAS float* OPS = (LAS float*)lds;
    LAS float* VV = (LAS float*)(lds + 12288);
    LAS float* OPL = (LAS float*)(lds + 28672);
    const bool helper = wave >= 4; const int ht = tid & 255;
    const int sd = ht & 15, st = ht >> 4, cfull = h * 128 + de * 16 + sd;
    const float lb = hgrn_lb(logits, layer, cfull);
    const int mbase = b * SEQ;
    const GAS float* zq = Z + (size_t)mbase * NCP + C_H + cfull; const GAS float* zf = zq + 512; const GAS float* zv = Z + (size_t)mbase * NCP + C_H + 1024 + h * 128;
    const int slot = (st * 4 + (sd >> 2)) * 12 + (sd & 3);
    GAS bf16* opo = OPB + (size_t)de * SZ + (size_t)mbase * 512 + h * 128;
    if (helper) {
        { const float f = zf[(size_t)st * NCP], q = zq[(size_t)st * NCP], fg = lb + (1.0f - lb) * sigm(f); OPS[slot] = fg; OPS[slot + 4] = 1.0f - fg; OPS[slot + 8] = q * sigm(q); }
#pragma unroll
        for (int i = 0; i < 8; ++i) { const int idx = ht + 256 * i; VV[idx] = zv[(size_t)(idx >> 7) * NCP + (idx & 127)]; } }
    __syncthreads();
    f32x2 S[4];
#pragma unroll
    for (int d = 0; d < 4; ++d) S[d] = (f32x2){0.f, 0.f};
    constexpr int NCH = SEQ / 16;
#define HG_REDUCE(cprev) do { const LAS float* ol = OPL + ((cprev) & 1) * 8192; _Pragma("unroll") for (int i = 0; i < 4; ++i) { const int idx = ht + 256 * i, t = idx >> 6, v = (idx & 63) * 2; \
        const f32x2 a0 = *(const LAS f32x2*)(ol + (t * 4 + 0) * 128 + v), a1 = *(const LAS f32x2*)(ol + (t * 4 + 1) * 128 + v), a2 = *(const LAS f32x2*)(ol + (t * 4 + 2) * 128 + v), a3 = *(const LAS f32x2*)(ol + (t * 4 + 3) * 128 + v); \
        const f32x2 sm = (a0 + a1) + (a2 + a3); *(GAS unsigned*)(opo + (size_t)((cprev) * 16 + t) * 512 + v) = pk2(sm.x, sm.y); } } while (0)
    float pf = 0.f, pq = 0.f, pv[8];
    if (helper) { pf = zf[(size_t)(16 + st) * NCP]; pq = zq[(size_t)(16 + st) * NCP];
#pragma unroll
        for (int i = 0; i < 8; ++i) { const int idx = ht + 256 * i; pv[i] = zv[(size_t)(16 + (idx >> 7)) * NCP + (idx & 127)]; } }
    for (int ci = 0; ci < NCH; ++ci) {
        if (helper) {
            if (ci + 1 < NCH) { LAS float* no = OPS + ((ci + 1) & 1) * 768; LAS float* nv = VV + ((ci + 1) & 1) * 2048;
                const float fg = lb + (1.0f - lb) * sigm(pf); no[slot] = fg; no[slot + 4] = 1.0f - fg; no[slot + 8] = pq * sigm(pq);
#pragma unroll
                for (int i = 0; i < 8; ++i) nv[ht + 256 * i] = pv[i]; }
            if (ci + 2 < NCH) { const size_t row = (size_t)(ci + 2) * 16; pf = zf[(row + st) * NCP]; pq = zq[(row + st) * NCP];
#pragma unroll
                for (int i = 0; i < 8; ++i) { const int idx = ht + 256 * i; pv[i] = zv[(row + (idx >> 7)) * NCP + (idx & 127)]; } }
            if (ci > 0) HG_REDUCE(ci - 1);
        } else {
            __builtin_amdgcn_s_setprio(3);
            const LAS float* co = OPS + (ci & 1) * 768; const LAS float* cv = VV + (ci & 1) * 2048; LAS float* ol = OPL + (ci & 1) * 8192;
            struct HgOps { f32x4 F, K, Q; float v0, v1; };
#define HG_LOAD(o, t_) do { const LAS float* ob = co + ((t_) * 4 + wave) * 12; (o).F = *(const LAS f32x4*)ob; (o).K = *(const LAS f32x4*)(ob + 4); (o).Q = *(const LAS f32x4*)(ob + 8); \
        (o).v0 = cv[(t_) * 128 + lane]; (o).v1 = cv[(t_) * 128 + 64 + lane]; asm volatile("" ::: "memory"); } while (0)
#define HG_STEP(o, t_) do { const f32x2 v2 = {(o).v0, (o).v1}; \
        S[0] = S[0] * (o).F.x + v2 * (o).K.x; S[1] = S[1] * (o).F.y + v2 * (o).K.y; S[2] = S[2] * (o).F.z + v2 * (o).K.z; S[3] = S[3] * (o).F.w + v2 * (o).K.w; \
        const f32x2 oa = (S[0] * (o).Q.x + S[1] * (o).Q.y) + (S[2] * (o).Q.z + S[3] * (o).Q.w); ol[((t_) * 4 + wave) * 128 + lane] = oa.x; ol[((t_) * 4 + wave) * 128 + 64 + lane] = oa.y; } while (0)
            HgOps hA, hB;
            HG_LOAD(hA, 0);
#pragma unroll 2
            for (int t = 0; t < 16; t += 2) { HG_LOAD(hB, t + 1); HG_STEP(hA, t); if (t + 2 < 16) HG_LOAD(hA, t + 2); HG_STEP(hB, t + 1); }
#undef HG_LOAD
#undef HG_STEP
        }
        __syncthreads();
    }
    if (helper) HG_REDUCE(NCH - 1);
    else { __builtin_amdgcn_s_setprio(0);
#pragma unroll
        for (int d = 0; d < 4; ++d) { Sout[(de * 16 + wave * 4 + d) * 128 + lane] = S[d].x; Sout[(de * 16 + wave * 4 + d) * 128 + 64 + lane] = S[d].y; } }
#undef HG_REDUCE
    __syncthreads();
}
__device__ __forceinline__ void m2_phase(ArgP A, int layer, LAS unsigned char* lds, int tid, int lane, int wave, int bid, int G) {
    const GAS float* Z = (const GAS float*)(A->ws + WS_A);
    const GAS float* RW = (const GAS float*)(A->ws + WS_B);
    GAS float* YR = (GAS float*)(A->ws + WS_C); GAS float* U = YR + SZ; const GAS float* VLN = U + SZ; GAS bf16* OPB = (GAS bf16*)(YR + 3 * SZ);
    const GAS float* logits = A->in[29];
    if (bid >= (G >> 1)) for (int job = bid - (G >> 1); job < 256; job += G - (G >> 1)) { const int b = job >> 6, n = (job >> 2) & 15, h = job & 3;
        sgu_job(lds, A->in[26] + ((size_t)layer * 4 + h) * 128 * 128, A->in[27] + (layer * 4 + h) * 128, VLN, U, b * SEQ + n * 128, h, tid); }
    LAS float* wbuf = (LAS float*)(lds + wave * 12288);
    for (int gw = bid * NWAVES + wave; gw < 2048; gw += G * NWAVES) {
        if (gw < 1024) { const int b = gw >> 3, h = gw & 7; const size_t so = (((size_t)layer * 128 + b) * 8 + h) * 4096;
            rwkv_sample_wave(wbuf, RW, MP + b * 4, h, A->in[2] + so, A->out + O_WKV_S + so, YR, lane); }
        else { const int j = gw - 1024, b = j >> 3, h = (j >> 1) & 3, vh = j & 1; const size_t so = (((size_t)layer * 128 + b) * 4 + h) * 16384;
            hgrn_sample_wave(wbuf, Z, logits, layer, b, h, vh, A->in[4] + so, A->out + O_HG_S + so, OPB, lane); }
    }
    __syncthreads();
    const int Gh = G >> 1;
    for (int rep_ = 0; rep_ < REP_M2; ++rep_) {
    if (bid < Gh) {
        if (wave < 4) for (int rr_ = 0; rr_ < REP_RWKV; ++rr_) for (int job = bid * 4 + wave; job < 512; job += Gh * 4) { const int b = job >> 7, h = (job >> 4) & 7, rq = job & 15;
            rwkv_prompt_wave4((LAS float*)(lds + wave * 30720), RW, b * SEQ, h, rq, A->out + O_WKV_P + (((size_t)layer * 4 + b) * 8 + h) * 4096, YR, lane); }
    } else {
        for (int rh_ = 0; rh_ < REP_HGRN; ++rh_) for (int job = bid - Gh; job < 128; job += G - Gh) { const int b = job >> 5, h = (job >> 3) & 3, de = job & 7;
            hgrn_prompt_job3(lds, Z, logits, layer, b, h, de, OPB, A->out + O_HG_P + (((size_t)layer * 4 + b) * 4 + h) * 16384, tid, lane, wave); }
    }
    }
}

template <int T> __device__ __forceinline__ void pool_window(const float (&hv)[15], const float (&zv)[T], int win, float inv_full, bool zero_hist, int tq0, LAS float* DT, int trow0, int j) {
    float P[16 + T]; P[0] = 0.f;
#pragma unroll
    for (int i = 0; i < 15; ++i) P[i + 1] = P[i] + hv[i];
#pragma unroll
    for (int t = 0; t < T; ++t) P[16 + t] = P[15 + t] + zv[t];
#pragma unroll
    for (int t = 0; t < T; ++t) { float lo = P[14 + t];
        if (win == 4) lo = P[12 + t]; else if (win == 8) lo = P[8 + t]; else if (win == 16) lo = P[t];
        float inv = inv_full; if (zero_hist) { const int n = tq0 + t + 1; inv = (n < win) ? 1.0f / (float)n : inv_full; }
        DT[(trow0 + t) * 512 + j] = (P[16 + t] - lo) * inv - zv[t]; }
}
__device__ __forceinline__ void m3_phase(ArgP A, int layer, LAS unsigned char* lds, int tid, int lane, int wave, int bid, int G) {
    const GAS float* Z = (const GAS float*)(A->ws + WS_A);
    const GAS float* RW = (const GAS float*)(A->ws + WS_B); const GAS float* RK = RW + 7 * SZ;
    const GAS float* YR = (const GAS float*)(A->ws + WS_C); const GAS float* U = YR + SZ; const GAS float* VLN = U + SZ; const GAS bf16* OPB = (const GAS bf16*)(YR + 3 * SZ);
    GAS bf16* YC = (GAS bf16*)(A->ws + WS_XN);
    const GAS float* gnw = A->in[22] + layer * 512; const GAS float* gnb = A->in[23] + layer * 512; const GAS float* sguw = A->in[26] + (size_t)layer * 4 * 128 * 128; const GAS float* sgub = A->in[27] + layer * 512;
    const GAS float* sgun = A->in[28] + layer * 512; const GAS float* hgn = A->in[30] + layer * 512; const GAS float* pw = A->in[31] + (size_t)layer * 4 * 128 * 128; const GAS float* psc = A->in[32] + layer * 512;
    const GAS float* pst = A->in[5] + (size_t)layer * 128 * 15 * 512;
    LAS float* P1 = (LAS float*)lds; LAS float* P2 = P1 + 128; LAS float* DT = (LAS float*)(lds + 1024);
    const int j = tid, wv = wave, hh = j >> 7, c = lane & 15, quad = lane >> 4, g = wv >> 1, colbase = (wv & 1) * 64;
    const int win = 2 << hh; const float inv_full = 1.0f / (float)win;
    const float gnw_j = gnw[j], gnb_j = gnb[j];
    bf16x8 bp[4][4];
#pragma unroll
    for (int ct = 0; ct < 4; ++ct)
#pragma unroll
        for (int kk = 0; kk < 4; ++kk) { float tb[8];
#pragma unroll
            for (int jj = 0; jj < 8; ++jj) tb[jj] = pw[(size_t)(g * 128 + kk * 32 + quad * 8 + jj) * 128 + colbase + ct * 16 + c];
            bp[kk][ct] = pack8(tb); }
    for (int tile = bid; tile < MT / 16; tile += G) {
        const int m0 = tile * 16;
        float us_t[16], o_t[16];
        if (m0 < MP) {
#pragma unroll
            for (int tg = 0; tg < 16; tg += 8) {
                float y4[8], u4[8], rk4[8], rv4[8], rg4[8]; unsigned q4[8][8];
#pragma unroll
                for (int i = 0; i < 8; ++i) { const int m = m0 + tg + i; const size_t mo = (size_t)m * 512 + j;
                    y4[i] = __builtin_nontemporal_load(&YR[mo]); u4[i] = __builtin_nontemporal_load(&U[mo]); rk4[i] = RK[m * 8 + wv]; rv4[i] = __builtin_nontemporal_load(&RW[3 * SZ + mo]); rg4[i] = __builtin_nontemporal_load(&RW[6 * SZ + mo]);
#pragma unroll
                    for (int pp = 0; pp < 8; ++pp) q4[i][pp] = __builtin_nontemporal_load(&OPB[(size_t)pp * SZ + mo]); }
#pragma unroll
                for (int i = 0; i < 8; ++i) { const int t = tg + i, m = m0 + t; const float y = y4[i], u = u4[i];
                    const float o = ((__builtin_bit_cast(float, q4[i][0] << 16) + __builtin_bit_cast(float, q4[i][1] << 16)) + (__builtin_bit_cast(float, q4[i][2] << 16) + __builtin_bit_cast(float, q4[i][3] << 16)))
                                  + ((__builtin_bit_cast(float, q4[i][4] << 16) + __builtin_bit_cast(float, q4[i][5] << 16)) + (__builtin_bit_cast(float, q4[i][6] << 16) + __builtin_bit_cast(float, q4[i][7] << 16)));
                    us_t[t] = u; o_t[t] = o;
                    const float r0 = wave_sum(y), r1 = wave_sum(y * y), r2 = wave_sum(u * u), r3 = wave_sum(o * o);
                    const float mean = r0 * (1.0f / 64.0f), var = fmaxf(r1 * (1.0f / 64.0f) - mean * mean, 0.f);
                    const float yn = (y - mean) * rsqrtf(var + 64e-5f) * gnw_j + gnb_j;
                    YC[(size_t)m * DM + j] = bf1((yn + rk4[i] * rv4[i]) * rg4[i]);
                    if (lane == 0) { P1[t * 8 + wv] = r2; P2[t * 8 + wv] = r3; } }
            }
        } else {
#pragma unroll
            for (int sq = 0; sq < 4; ++sq) {
                float y4[4], u4[4], vl4[4], rk4[4], rv4[4], rg4[4], bb4[4], w4[4][4]; unsigned qa[4], qb[4];
#pragma unroll
                for (int i = 0; i < 4; ++i) { const int m = m0 + sq * 4 + i; const size_t mo = (size_t)m * 512 + j;
                    y4[i] = YR[mo]; u4[i] = U[mo]; vl4[i] = VLN[mo]; rk4[i] = RK[m * 8 + wv]; rv4[i] = RW[3 * SZ + mo]; rg4[i] = RW[6 * SZ + mo]; qa[i] = OPB[mo]; qb[i] = OPB[SZ + mo]; bb4[i] = sgub[hh * 128 + i];
#pragma unroll
                    for (int sp = 0; sp < 4; ++sp) w4[i][sp] = (sp <= i) ? sguw[(hh * 128 + i) * 128 + sp] : 0.f; }
#pragma unroll
                for (int i = 0; i < 4; ++i) { const int t = sq * 4 + i, m = m0 + t; const float y = y4[i];
                    const float sacc = bb4[i] + ((w4[i][0] * vl4[0] + w4[i][1] * vl4[1]) + (w4[i][2] * vl4[2] + w4[i][3] * vl4[3]));
                    const float u = u4[i] * sacc; const float o = __builtin_bit_cast(float, qa[i] << 16) + __builtin_bit_cast(float, qb[i] << 16);
                    us_t[t] = u; o_t[t] = o;
                    const float r0 = wave_sum(y), r1 = wave_sum(y * y), r2 = wave_sum(u * u), r3 = wave_sum(o * o);
                    const float mean = r0 * (1.0f / 64.0f), var = fmaxf(r1 * (1.0f / 64.0f) - mean * mean, 0.f);
                    const float yn = (y - mean) * rsqrtf(var + 64e-5f) * gnw_j + gnb_j;
                    YC[(size_t)m * DM + j] = bf1((yn + rk4[i] * rv4[i]) * rg4[i]);
                    if (lane == 0) { P1[t * 8 + wv] = r2; P2[t * 8 + wv] = r3; } }
            }
        }
        if (m0 < MP) {
            const int tq0 = m0 & (SEQ - 1); const bool zh = (tq0 == 0); float hv[15], zv[16];
#pragma unroll
            for (int i = 0; i < 15; ++i) hv[i] = zh ? 0.f : Z[(size_t)(m0 - 15 + i) * NCP + C_P + j];
#pragma unroll
            for (int t = 0; t < 16; ++t) zv[t] = Z[(size_t)(m0 + t) * NCP + C_P + j];
            pool_window<16>(hv, zv, win, inv_full, zh, tq0, DT, 0, j);
            if (tq0 == SEQ - 16) {
#pragma unroll
                for (int i = 0; i < 15; ++i) A->out[O_PL_P + (((size_t)layer * 4 + (m0 >> 11)) * 15 + i) * 512 + j] = zv[i + 1]; }
        } else {
#pragma unroll
            for (int sq = 0; sq < 4; ++sq) { const int bq = ((m0 - MP) >> 2) + sq; float hv[15], zv[4];
#pragma unroll
                for (int i = 0; i < 15; ++i) hv[i] = pst[((size_t)bq * 15 + i) * 512 + j];
#pragma unroll
                for (int t = 0; t < 4; ++t) zv[t] = Z[(size_t)(m0 + sq * 4 + t) * NCP + C_P + j];
                pool_window<4>(hv, zv, win, inv_full, false, 0, DT, sq * 4, j);
#pragma unroll
                for (int i = 0; i < 15; ++i) A->out[O_PL_S + (((size_t)layer * 128 + bq) * 15 + i) * 512 + j] = (i < 11) ? hv[i + 4] : zv[i - 11]; }
        }
        __syncthreads();
        float gz16[16];
#pragma unroll
        for (int t = 0; t < 16; ++t) gz16[t] = Z[(size_t)(m0 + t) * NCP + C_H + 1536 + j];
#pragma unroll
        for (int t = 0; t < 16; ++t) { const int m = m0 + t;
            float s1 = 0.f;
#pragma unroll
            for (int w = 0; w < 8; ++w) s1 += P1[t * 8 + w];
            YC[(size_t)m * DM + 512 + j] = bf1(us_t[t] * rsqrtf(s1 * (1.0f / 512.0f) + 1e-6f) * sgun[j]);
            const float s2 = P2[t * 8 + (wv & ~1)] + P2[t * 8 + (wv | 1)]; const float gz = gz16[t];
            YC[(size_t)m * DM + 1024 + j] = bf1(o_t[t] * rsqrtf(s2 * (1.0f / 128.0f) + 1e-6f) * hgn[j] * gz * sigm(gz)); }
        {
            bf16x8 ap[4];
#pragma unroll
            for (int kk = 0; kk < 4; ++kk) { const LAS float* dp = DT + c * 512 + g * 128 + kk * 32 + quad * 8; const f32x4 d0 = *(const LAS f32x4*)dp, d1 = *(const LAS f32x4*)(dp + 4);
                const float t[8] = {d0.x, d0.y, d0.z, d0.w, d1.x, d1.y, d1.z, d1.w}; ap[kk] = pack8(t); }
#pragma unroll
            for (int ct = 0; ct < 4; ++ct) { f32x4 acc = {0.f, 0.f, 0.f, 0.f}; const int cl = colbase + ct * 16 + c;
#pragma unroll
                for (int kk = 0; kk < 4; ++kk) acc = __builtin_amdgcn_mfma_f32_16x16x32_bf16(ap[kk], bp[kk][ct], acc, 0, 0, 0);
                const int col = g * 128 + cl; const float sc = psc[col];
#pragma unroll
                for (int jj = 0; jj < 4; ++jj) YC[(size_t)(m0 + quad * 4 + jj) * DM + 1536 + col] = bf1(acc[jj] * sc); }
        }
        __syncthreads();
    }
}
#ifndef REP_GEMM
#define REP_GEMM 1
#endif
#ifndef REP_M1
#define REP_M1 1
#endif
#ifndef REP_M2
#define REP_M2 1
#endif
#ifndef REP_M3
#define REP_M3 1
#endif
#ifndef REP_P0
#define REP_P0 1
#endif
#ifndef REP_ROW
#define REP_ROW 1
#endif
#ifndef MK_MULTI
#define MK_MULTI 0
#endif
__global__ void __launch_bounds__(NTHR, 2) mega_fwd(Args A_unused) {
    extern __shared__ __attribute__((aligned(16))) unsigned char lds_[];
    cg::grid_group grid = cg::this_grid();
    LAS unsigned char* lds = (LAS unsigned char*)lds_;
    const int bid = blockIdx.x, G = gridDim.x;
    volatile LAS unsigned* xst = (volatile LAS unsigned*)(lds + LDS_BYTES - 64);
    if (threadIdx.x < 16) xst[threadIdx.x] = 0u;
    __syncthreads();
    XcdBarrier xbar; { ArgP A = largs(); xbar = xcd_barrier_post((unsigned*)(A->ws + WS_CTL), xst); }
#define TL const int tid = ltid(), lane = tid & 63, wave = __builtin_amdgcn_readfirstlane(tid >> 6); (void)tid; (void)lane; (void)wave;
    int lo, hi; { ArgP A = largs(); lo = A->ph_lo; hi = A->ph_hi; }
#define GEMM_PRE ArgP A = largs(); GAS unsigned char* wb = A->ws + (size_t)layer * WL_BYTES; const bf16* XN = (const bf16*)(A->ws + WS_XN);
#define INP(k) (lo <= (k) && (k) < hi)
#ifndef REP_SYNC
#define REP_SYNC 1
#endif
#define SEAM(k) do { if (lo <= (k) && (k) + 1 < hi) for (int rs_ = 0; rs_ < REP_SYNC; ++rs_) { if (lo < 0) grid.sync(); else xcd_barrier(xbar); }     } while (0)
#ifndef SKIP_P0
    if (INP(0)) { TL for (int rep_ = 0; rep_ < REP_P0; ++rep_) p0_prologue(largs(), lds, tid, lane, wave, bid, G); }
#endif
    SEAM(0);
#pragma unroll
    for (int layer = 0; layer < 2; ++layer) {
        const int pb = 1 + layer * 11;
        if (layer > 0) { if (INP(pb + 0)) { TL for (int rep_ = 0; rep_ < REP_ROW; ++rep_) rowA_phase(largs(), layer, lane, wave, bid, G); } SEAM(pb + 0); }
        if (INP(pb + 1)) {
            GEMM_PRE
            pg8::Gemm g{XN, (const bf16*)(wb + WO_IN), MT, NCP, DM, DM}; pg8::StaticOrder S; S.init(MT, NCP, G, bid);
            pg8::EpiF32P E{(float*)(A->ws + WS_A), NCP};
#ifndef SKIP_G1
            for (int rep_ = 0; rep_ < REP_GEMM; ++rep_) pg8::gemm_phase<pg8::EpiF32P, pg8::StaticOrder, true, true>(lds, g, S, E);
#endif
 }
        SEAM(pb + 1);
#ifndef SKIP_M1
        if (INP(pb + 2)) { TL for (int rep_ = 0; rep_ < REP_M1; ++rep_) m1_phase(largs(), layer, lds, tid, lane, wave, bid, G); }
#endif
        SEAM(pb + 2);
#ifndef SKIP_M2
        if (INP(pb + 3)) { TL m2_phase(largs(), layer, lds, tid, lane, wave, bid, G); }
#endif
        SEAM(pb + 3);
#ifndef SKIP_M3
        if (INP(pb + 4)) { TL for (int rep_ = 0; rep_ < REP_M3; ++rep_) m3_phase(largs(), layer, lds, tid, lane, wave, bid, G); }
#endif
        SEAM(pb + 4);
        if (INP(pb + 5)) {
            GEMM_PRE
            { pg8::Gemm g{XN, (const bf16*)(wb + WO_OUT), MP, DM, DM, DM}; pg8::StaticOrder S; S.init(MP, DM, G, bid);
              pg8::EpiF32 E{(float*)(A->ws + WS_MIX), DM};
              pg8::gemm_phase<pg8::EpiF32, pg8::StaticOrder, true, true>(lds, g, S, E); }
            { pg8::Gemm g{XN, (const bf16*)(wb + WO_OUT), MT, DM, 256, DM}; pg8::TailOrder S; S.init(bid, 8, 256, 32);
              pg8::EpiF32 E{(float*)(A->ws + WS_C) + (size_t)(bid % 8) * MS * DM - (size_t)MP * DM, DM};

#ifndef SKIP_TAIL
              pg8::gemm_phase<pg8::EpiF32, pg8::TailOrder, true, true>(lds, g, S, E);
#endif
 }
            { pg8::Gemm g{(const bf16*)(A->ws + WS_PB) + (size_t)layer * MT * PLED, (const bf16*)(wb + WO_PL), MT, DM, PLED, PLED}; pg8::StaticOrder S; S.init(MT, DM, G, (bid + 128) % G);
              pg8::EpiF32 E{(float*)(A->ws + WS_PLE), DM};
#ifndef SKIP_GP
              for (int rep_ = 0; rep_ < REP_GEMM; ++rep_) pg8::gemm_phase<pg8::EpiF32, pg8::StaticOrder, true, true>(lds, g, S, E);
#endif
 } }
        SEAM(pb + 5);
        if (INP(pb + 6)) { TL for (int rep_ = 0; rep_ < REP_ROW; ++rep_) rowB_phase(largs(), layer, lane, wave, bid, G); }
        SEAM(pb + 6);
        if (INP(pb + 7)) {
            GEMM_PRE
            pg8::Gemm g{XN, (const bf16*)(wb + WO_GU), MT, 2 * DFF, DM, DM}; pg8::StaticOrder S; S.init(MT, 2 * DFF, G, bid);
            pg8::EpiSwiglu E{(bf16*)(A->ws + WS_A), DFF};
#ifndef SKIP_GU
            for (int rep_ = 0; rep_ < REP_GEMM; ++rep_) pg8::gemm_phase<pg8::EpiSwiglu, pg8::StaticOrder, true, true>(lds, g, S, E);
#endif
 }
        SEAM(pb + 7);
        if (INP(pb + 8)) {
            GEMM_PRE
            { pg8::Gemm g{(const bf16*)(A->ws + WS_A), (const bf16*)(wb + WO_DN), MP, DM, DFF, DFF}; pg8::StaticOrder S; S.init(MP, DM, G, bid);
              pg8::EpiF32 E{(float*)(A->ws + WS_MIX), DM};
              pg8::gemm_phase<pg8::EpiF32, pg8::StaticOrder, true, true>(lds, g, S, E); }
            { pg8::Gemm g{(const bf16*)(A->ws + WS_A), (const bf16*)(wb + WO_DN), MT, DM, 512, DFF}; pg8::TailOrder S; S.init(bid, 11, 512, 32);
              pg8::EpiF32 E{(float*)(A->ws + WS_C) + (size_t)(bid % 11) * MS * DM - (size_t)MP * DM, DM};

#ifndef SKIP_TAIL
              pg8::gemm_phase<pg8::EpiF32, pg8::TailOrder, true, true>(lds, g, S, E);
#endif
 } }
        SEAM(pb + 8);
        if (INP(pb + 9)) { TL rowC_phase(largs(), layer, lane, wave, bid, G); }
        SEAM(pb + 9);
        if (INP(pb + 10)) {  GEMM_PRE
            { pg8::Gemm g{XN, (const bf16*)(wb + WO_GT), MP, DM, DM, DM}; pg8::StaticOrder S; S.init(MP, DM, G, bid);
              pg8::EpiGate E{(const float*)(A->ws + WS_XF), (const float*)(A->ws + WS_PLE), (float*)(A->out + O_Y), DM};
              pg8::gemm_phase<pg8::EpiGate, pg8::StaticOrder, true, true>(lds, g, S, E); }
            { pg8::Gemm g{XN, (const bf16*)(wb + WO_GT), MT, DM, 256, DM}; pg8::TailOrder S; S.init(bid, 8, 256, 32);
              pg8::EpiF32 E{(float*)(A->ws + WS_C) + (size_t)(bid % 8) * MS * DM - (size_t)MP * DM, DM};

#ifndef SKIP_TAIL
              pg8::gemm_phase<pg8::EpiF32, pg8::TailOrder, true, true>(lds, g, S, E);
#endif
 } }
        SEAM(pb + 10);
    }
    if (INP(23)) { TL final_phase(largs(), lane, wave, bid, G); }
#undef INP
#undef SEAM
}

extern "C" void kernel_launch(void* const* d_in, const int* in_sizes, int n_in, void* d_out, int out_size, void* d_ws, size_t ws_size, hipStream_t stream) {
    static int grid = 0;
    if (grid == 0) {
        if (n_in != 38 || out_size != 46777600 || ws_size < WS_END) { fprintf(stderr, "kernel_launch: unexpected shapes (n_in %d, out %d, ws %zu < %zu); nothing launched\n", n_in, out_size, ws_size, (size_t)WS_END); grid = -1; return; }
        int dev = 0, cus = 0, per_cu = 0;
        (void)hipGetDevice(&dev); (void)hipDeviceGetAttribute(&cus, hipDeviceAttributeMultiprocessorCount, dev);
        if (hipFuncSetAttribute((const void*)mega_fwd, hipFuncAttributeMaxDynamicSharedMemorySize, LDS_BYTES) != hipSuccess) { fprintf(stderr, "kernel_launch: hipFuncSetAttribute failed\n"); grid = -1; return; }
        if (hipOccupancyMaxActiveBlocksPerMultiprocessor(&per_cu, (const void*)mega_fwd, NTHR, LDS_BYTES) != hipSuccess || per_cu < 1) { fprintf(stderr, "kernel_launch: occupancy query says %d workgroups per CU\n", per_cu); per_cu = 1; }
        (void)hipGetLastError();
        grid = cus * 1;
        if (grid < 2) grid = 2;
    }
    if (grid < 0) return;
    if (hipMemsetAsync((char*)d_ws + WS_CTL, 0, CTL_BYTES, stream) != hipSuccess) { fprintf(stderr, "kernel_launch: memset of the barrier words failed\n"); return; }
    Args a{};
    for (int i = 0; i < 38; ++i) a.in[i] = (const float*)d_in[i];
    a.out = (float*)d_out; a.ws = (unsigned char*)d_ws;
#if MK_MULTI
    for (int ph = 0; ph < NPH; ++ph) { if (ph == 1) continue; a.ph_lo = ph; a.ph_hi = ph + 1; void* args[] = {&a};
        hipError_t e = hipLaunchCooperativeKernel((const void*)mega_fwd, dim3(grid), dim3(NTHR), args, LDS_BYTES, stream);
        if (e != hipSuccess) { fprintf(stderr, "kernel_launch: launch of phase %d failed: %s\n", ph, hipGetErrorString(e)); break; } }
#else
    a.ph_lo = 0; a.ph_hi = NPH; void* args[] = {&a};
    hipError_t e = hipLaunchCooperativeKernel((const void*)mega_fwd, dim3(grid), dim3(NTHR), args, LDS_BYTES, stream);
    if (e != hipSuccess) fprintf(stderr, "kernel_launch: cooperative launch failed: %s (grid %d)\n", hipGetErrorString(e), grid);
#endif
}
```

```cpp
#include <hip/hip_runtime.h>
#include <hip/hip_cooperative_groups.h>
#include <cstdio>
#include <cstdint>
namespace cg = cooperative_groups;
__device__ __forceinline__ int ltid() { int t = threadIdx.x; asm volatile("" : "+v"(t)); return t; }
#ifndef REP_M2
#define REP_M2 1
#endif
#ifndef REP_RWKV
#define REP_RWKV 1
#endif
#ifndef REP_HGRN
#define REP_HGRN 1
#endif
namespace pg8 {
#define PG8_LAS __attribute__((address_space(3)))
typedef unsigned short bf16_t;
typedef short bf16x8 __attribute__((ext_vector_type(8)));
typedef float f32x4 __attribute__((ext_vector_type(4)));
typedef unsigned u32x4 __attribute__((ext_vector_type(4)));
constexpr int BM = 256, BK = 64, HALF = 128, HTB = HALF * BK * 2  , STAGE_BYTES = 8 * HTB, NXCD = 8, WGM = 8;

__host__ __device__ __forceinline__ int lds_byte(int r, int c) { const int st = (r >> 4) * 2 + (c >> 5), rr = r & 15, cc = c & 31, ob = rr * 64 + cc * 2; return st * 1024 + (ob ^ (((ob >> 9) & 1) << 5)); }
__host__ __device__ __forceinline__ void stage_rc(int b, int& R, int& C) { const int st = b / 1024, sb = b % 1024, swz = sb ^ (((sb >> 9) & 1) << 5); R = (st >> 1) * 16 + swz / 64; C = (st & 1) * 32 + (swz % 64) / 2; }
__host__ __device__ __forceinline__ int perm32(int rho) { const int n = rho >> 4, i = rho & 15; return 8 * (i >> 2) + 4 * n + (i & 3); }

struct Unit { int pm, pn, k0; };
struct Gemm { const bf16_t* A; const bf16_t* Bt; int M, N, K, ld; };

struct StaticOrder {
    int nM, nN, nwg, G, c;
    __host__ __device__ void init(int M, int N, int G_, int c_) { nM = M / BM; nN = N / BM; nwg = nM * nN; G = G_; c = c_; }
    __host__ __device__ bool next(int i, Unit& u) const {
        const long L = (long)i * G + c; if (L >= nwg) return false;
        int wgid = (int)L; { const int q = nwg / NXCD, r = nwg % NXCD, xcd = wgid % NXCD, off = wgid / NXCD; wgid = (xcd < r ? xcd * (q + 1) : r * (q + 1) + (xcd - r) * q) + off; }
        const int nig = WGM * nN, gid = wgid / nig, fm = gid * WGM, gsz = (nM - fm) < WGM ? (nM - fm) : WGM;
        u.pm = fm + ((wgid % nig) % gsz); u.pn = (wgid % nig) / gsz; u.k0 = 0; return true;
    }
    __device__ __forceinline__ void a_ready(const Unit&) const {}
    __device__ __forceinline__ void done(const Unit&) const {}
};

__device__ __forceinline__ unsigned cvt_pk_bf16(float lo, float hi) { unsigned r; asm volatile("v_cvt_pk_bf16_f32 %0, %1, %2" : "=v"(r) : "v"(lo), "v"(hi)); return r; }
struct TailOrder {
    int c, S_, kr, pm0;
    __host__ __device__ void init(int c_, int s, int krange, int pm0_) { c = c_; S_ = s; kr = krange; pm0 = pm0_; }
    __host__ __device__ bool next(int i, Unit& u) const { if (i > 0 || c >= 16 * S_) return false; const int t = c / S_, ks = c - t * S_; u.pm = pm0 + (t >> 3); u.pn = t & 7; u.k0 = ks * kr; return true; }
    __device__ __forceinline__ void a_ready(const Unit&) const {}
    __device__ __forceinline__ void done(const Unit&) const {}
};
struct EpiF32 {
    static constexpr bool PERM = false, AFTER_DRAIN = false;
    float* O; int ldc;
    __device__ __forceinline__ void operator()(const f32x4 (&acc)[2][2][4][2], const Unit& u, int wr, int wc, int fr, int fq) const {
#pragma unroll
        for (int ai = 0; ai < 2; ++ai)
#pragma unroll
            for (int m = 0; m < 4; ++m) { float* rowp = O + (size_t)(u.pm * BM + ai * HALF + wr * 64 + m * 16 + fr) * ldc + u.pn * BM + wc * 32 + 4 * fq;
#pragma unroll
                for (int bj = 0; bj < 2; ++bj)
#pragma unroll
                    for (int n = 0; n < 2; ++n) *(__attribute__((address_space(1))) f32x4*)(rowp + bj * HALF + n * 16) = acc[ai][bj][m][n]; }
    }
};
struct EpiSwiglu {
    static constexpr bool PERM = false, AFTER_DRAIN = false;
    bf16_t* O; int ldc;
    __device__ __forceinline__ void operator()(const f32x4 (&acc)[2][2][4][2], const Unit& u, int wr, int wc, int fr, int fq) const {
        typedef unsigned u32x2 __attribute__((ext_vector_type(2)));
#pragma unroll
        for (int ai = 0; ai < 2; ++ai)
#pragma unroll
            for (int m = 0; m < 4; ++m) { bf16_t* rowp = O + (size_t)(u.pm * BM + ai * HALF + wr * 64 + m * 16 + fr) * ldc + u.pn * HALF + wc * 32 + 4 * fq;
#pragma unroll
                for (int n = 0; n < 2; ++n) { const f32x4 g = acc[ai][0][m][n], up = acc[ai][1][m][n]; float h[4];
#pragma unroll
                    for (int j = 0; j < 4; ++j) h[j] = g[j] / (1.0f + __expf(-g[j])) * up[j];
                    u32x2 w; w.x = cvt_pk_bf16(h[0], h[1]); w.y = cvt_pk_bf16(h[2], h[3]); *(__attribute__((address_space(1))) u32x2*)(rowp + n * 16) = w; } }
    }
};
struct EpiGate {
    static constexpr bool PERM = false, AFTER_DRAIN = false;
    const float* XF; const float* PL; float* O; int ldc;
    __device__ __forceinline__ void operator()(const f32x4 (&acc)[2][2][4][2], const Unit& u, int wr, int wc, int fr, int fq) const {
#pragma unroll
        for (int ai = 0; ai < 2; ++ai)
#pragma unroll
            for (int m = 0; m < 4; ++m) { const size_t off = (size_t)(u.pm * BM + ai * HALF + wr * 64 + m * 16 + fr) * ldc + u.pn * BM + wc * 32 + 4 * fq;
#pragma unroll
                for (int bj = 0; bj < 2; ++bj)
#pragma unroll
                    for (int n = 0; n < 2; ++n) { const size_t o2 = off + bj * HALF + n * 16; const f32x4 a = acc[ai][bj][m][n], xf = __builtin_nontemporal_load((const __attribute__((address_space(1))) f32x4*)(XF + o2)), pl = __builtin_nontemporal_load((const __attribute__((address_space(1))) f32x4*)(PL + o2)); f32x4 o;
#pragma unroll
                        for (int j = 0; j < 4; ++j) o[j] = xf[j] + pl[j] / (1.0f + __expf(-a[j]));
                        *(__attribute__((address_space(1))) f32x4*)(O + o2) = o; } }
    }
};
struct EpiF32P {
    static constexpr bool PERM = true, AFTER_DRAIN = false;
    float* O; int ldc;
    __device__ __forceinline__ void operator()(const f32x4 (&acc)[2][2][4][2], const Unit& u, int wr, int wc, int fr, int fq) const {
#pragma unroll
        for (int ai = 0; ai < 2; ++ai)
#pragma unroll
            for (int m = 0; m < 4; ++m) { float* rowp = O + (size_t)(u.pm * BM + ai * HALF + wr * 64 + m * 16 + fr) * ldc + u.pn * BM + wc * 32 + 8 * fq;
#pragma unroll
                for (int bj = 0; bj < 2; ++bj)
#pragma unroll
                    for (int n = 0; n < 2; ++n) *(__attribute__((address_space(1))) f32x4*)(rowp + bj * HALF + n * 4) = acc[ai][bj][m][n]; }
    }
};

template <class Epi, class Sched, bool ALIGN_EPI = false, bool SP2 = false>
__device__ __forceinline__ void gemm_phase(PG8_LAS unsigned char* lds, const Gemm g, const Sched& S, const Epi& E) {
    const int tid = ltid(), wid = __builtin_amdgcn_readfirstlane(tid >> 6), lane = tid & 63, wr = wid >> 2, wc = wid & 3, fr = lane & 15, fq = lane >> 4;
    const int K = g.K, nt = K / BK, ld = g.ld;
    unsigned voffA[2], voffB[2];
#pragma unroll
    for (int i = 0; i < 2; ++i) { int R, C; stage_rc(tid * 16 + i * 8192, R, C); const int Rb = Epi::PERM ? ((R & ~31) + perm32(R & 31)) : R;
        voffA[i] = (unsigned)(R * ld + C) * 2u; voffB[i] = (unsigned)(Rb * ld + C) * 2u; }
    const size_t kstep = (size_t)(BK * 2);
    const size_t hstep = (size_t)HALF * ld * 2;
    const size_t tstep = 2 * hstep;
    const unsigned ldsw = (unsigned)wid * 1024u;
    const int aoff = lds_byte(wr * 64 + fr, fq * 8), boff = lds_byte(wc * 32 + fr, fq * 8);
#define PG8_SA(b, h) (((b) * 2 + (h)) * HTB)
#define PG8_SB(b, h) ((4 + (b) * 2 + (h)) * HTB)
#define PG8_STAGE(bufoff, gbase, voff) do { _Pragma("unroll") for (int _i = 0; _i < 2; ++_i) \
        __builtin_amdgcn_global_load_lds((const unsigned*)((const char*)(gbase) + (voff)[_i]), (PG8_LAS unsigned*)(lds + (bufoff) + ldsw + _i * 8192), 16, 0, 0); } while (0)
#define PG8_LDA(dst, b, h) do { _Pragma("unroll") for (int m = 0; m < 4; ++m) _Pragma("unroll") for (int k = 0; k < 2; ++k) dst[m][k] = *(const PG8_LAS bf16x8*)(lds + PG8_SA(b, h) + aoff + m * 2048 + k * 1024); } while (0)
#define PG8_LDB(dst, b, h) do { _Pragma("unroll") for (int n = 0; n < 2; ++n) _Pragma("unroll") for (int k = 0; k < 2; ++k) dst[n][k] = *(const PG8_LAS bf16x8*)(lds + PG8_SB(b, h) + boff + n * 2048 + k * 1024); } while (0)
#define PG8_MMA(ai, bj, At, Bt) do { __builtin_amdgcn_s_setprio(1); _Pragma("unroll") for (int m = 0; m < 4; ++m) _Pragma("unroll") for (int n = 0; n < 2; ++n) _Pragma("unroll") for (int k = 0; k < 2; ++k) \
        acc[ai][bj][m][n] = __builtin_amdgcn_mfma_f32_16x16x32_bf16(Bt[n][k], At[m][k], acc[ai][bj][m][n], 0, 0, 0); __builtin_amdgcn_s_setprio(0); } while (0)
#define PG8_WAIT_V(n) asm volatile("s_waitcnt vmcnt(" #n ")" ::: "memory")
#define PG8_WAIT_L(n) asm volatile("s_waitcnt lgkmcnt(" #n ")" ::: "memory")
#define PG8_BAR __builtin_amdgcn_s_barrier()
#define PG8_SCHED __builtin_amdgcn_sched_barrier(0)
    Unit cur, nxt; int ui = 0;
    if (!S.next(0, cur)) return;
    f32x4 acc[2][2][4][2];
#pragma unroll
    for (int a = 0; a < 2; ++a)
#pragma unroll
        for (int b = 0; b < 2; ++b)
#pragma unroll
            for (int m = 0; m < 4; ++m)
#pragma unroll
                for (int n = 0; n < 2; ++n) acc[a][b][m][n] = (f32x4){0.f, 0.f, 0.f, 0.f};
    bf16x8 At[4][2], B0[2][2], B1[2][2];
    const char* cA = (const char*)g.A + (size_t)cur.pm * tstep + (size_t)cur.k0 * 2; const char* cB = (const char*)g.Bt + (size_t)cur.pn * tstep + (size_t)cur.k0 * 2;
    S.a_ready(cur);
    if constexpr (SP2) {
        PG8_STAGE(PG8_SB(0, 0), cB, voffB); PG8_STAGE(PG8_SB(0, 1), cB + hstep, voffB); PG8_STAGE(PG8_SA(0, 0), cA, voffA); PG8_STAGE(PG8_SA(0, 1), cA + hstep, voffA);
        if (wr == 1) PG8_BAR;
        PG8_WAIT_V(2); PG8_BAR;
        PG8_STAGE(PG8_SB(1, 0), cB + kstep, voffB); PG8_STAGE(PG8_SA(1, 0), cA + kstep, voffA); PG8_STAGE(PG8_SB(1, 1), cB + hstep + kstep, voffB);
        PG8_WAIT_V(6); PG8_BAR;
    } else {
        PG8_STAGE(PG8_SB(0, 0), cB, voffB); PG8_STAGE(PG8_SA(0, 0), cA, voffA); PG8_STAGE(PG8_SB(0, 1), cB + hstep, voffB); PG8_STAGE(PG8_SA(0, 1), cA + hstep, voffA);
        if (wr == 1) PG8_BAR;
        PG8_WAIT_V(4); PG8_BAR;
        PG8_STAGE(PG8_SB(1, 0), cB + kstep, voffB); PG8_STAGE(PG8_SA(1, 0), cA + kstep, voffA); PG8_STAGE(PG8_SB(1, 1), cB + hstep + kstep, voffB);
        PG8_WAIT_V(6); PG8_BAR;
    }
    for (;;) {
        const bool has_next = S.next(ui + 1, nxt);
        const char* nA = has_next ? (const char*)g.A + (size_t)nxt.pm * tstep + (size_t)nxt.k0 * 2 : cA; const char* nB = has_next ? (const char*)g.Bt + (size_t)nxt.pn * tstep + (size_t)nxt.k0 * 2 : cB;
        for (int t = 0; t < nt; t += 2) {
            const bool last = (t == nt - 2);
            const char* a1 = cA + (size_t)(t + 1) * kstep;
            const char* a2 = last ? nA : cA + (size_t)(t + 2) * kstep; const char* b2 = last ? nB : cB + (size_t)(t + 2) * kstep;
            const char* a3 = a2 + kstep; const char* b3 = b2 + kstep;
            if (last && has_next) S.a_ready(nxt);
            if constexpr (SP2) {
            PG8_LDB(B0, 0, 0); PG8_LDB(B1, 0, 1); PG8_SCHED; PG8_LDA(At, 0, 0); PG8_STAGE(PG8_SA(1, 1), a1 + hstep, voffA);
            PG8_WAIT_V(8); PG8_WAIT_L(0); PG8_BAR; PG8_MMA(0, 0, At, B0); PG8_MMA(0, 1, At, B1); PG8_BAR; PG8_SCHED;
            PG8_LDA(At, 0, 1); PG8_STAGE(PG8_SB(0, 0), b2, voffB); PG8_STAGE(PG8_SB(0, 1), b2 + hstep, voffB); PG8_STAGE(PG8_SA(0, 0), a2, voffA);
            PG8_WAIT_V(8); PG8_WAIT_L(0); PG8_BAR; PG8_MMA(1, 0, At, B0); PG8_MMA(1, 1, At, B1); PG8_BAR; PG8_SCHED;
            PG8_LDB(B0, 1, 0); PG8_LDB(B1, 1, 1); PG8_SCHED; PG8_LDA(At, 1, 0); PG8_STAGE(PG8_SA(0, 1), a2 + hstep, voffA);
            PG8_WAIT_V(8); PG8_WAIT_L(0); PG8_BAR; PG8_MMA(0, 0, At, B0); PG8_MMA(0, 1, At, B1); PG8_BAR; PG8_SCHED;
            PG8_LDA(At, 1, 1); PG8_STAGE(PG8_SB(1, 0), b3, voffB); PG8_STAGE(PG8_SB(1, 1), b3 + hstep, voffB); PG8_STAGE(PG8_SA(1, 0), a3, voffA);
            PG8_WAIT_V(8); PG8_WAIT_L(0); PG8_BAR; PG8_MMA(1, 0, At, B0); PG8_MMA(1, 1, At, B1); PG8_BAR; PG8_SCHED;
            } else {
            PG8_LDB(B0, 0, 0); PG8_SCHED; PG8_LDA(At, 0, 0); PG8_STAGE(PG8_SA(1, 1), a1 + hstep, voffA);
            PG8_WAIT_L(8); PG8_BAR; PG8_WAIT_L(0); PG8_MMA(0, 0, At, B0); PG8_BAR; PG8_SCHED;
            PG8_LDB(B1, 0, 1); PG8_STAGE(PG8_SB(0, 0), b2, voffB);
            PG8_BAR; PG8_WAIT_L(0); PG8_MMA(0, 1, At, B1); PG8_BAR;
            PG8_LDA(At, 0, 1); PG8_STAGE(PG8_SA(0, 0), a2, voffA);
            PG8_BAR; PG8_WAIT_L(0); PG8_MMA(1, 0, At, B0); PG8_BAR; PG8_SCHED;
            PG8_STAGE(PG8_SB(0, 1), b2 + hstep, voffB);
            PG8_WAIT_V(6); PG8_BAR; PG8_MMA(1, 1, At, B1); PG8_BAR;
            PG8_LDB(B0, 1, 0); PG8_SCHED; PG8_LDA(At, 1, 0); PG8_STAGE(PG8_SA(0, 1), a2 + hstep, voffA);
            PG8_WAIT_L(8); PG8_BAR; PG8_WAIT_L(0); PG8_MMA(0, 0, At, B0); PG8_BAR; PG8_SCHED;
            PG8_LDB(B1, 1, 1); PG8_STAGE(PG8_SB(1, 0), b3, voffB);
            PG8_BAR; PG8_WAIT_L(0); PG8_MMA(0, 1, At, B1); PG8_BAR;
            PG8_LDA(At, 1, 1); PG8_STAGE(PG8_SA(1, 0), a3, voffA);
            PG8_BAR; PG8_WAIT_L(0); PG8_MMA(1, 0, At, B0); PG8_BAR; PG8_SCHED;
            PG8_STAGE(PG8_SB(1, 1), b3 + hstep, voffB);
            PG8_WAIT_V(6); PG8_BAR; PG8_MMA(1, 1, At, B1); PG8_BAR;
            }
        }
        if constexpr (ALIGN_EPI) { if (wr == 0) PG8_BAR; }
        if constexpr (!Epi::AFTER_DRAIN) { E(acc, cur, wr, wc, fr, fq); S.done(cur); }
        if (!has_next) break;
#pragma unroll
        for (int a = 0; a < 2; ++a)
#pragma unroll
            for (int b = 0; b < 2; ++b)
#pragma unroll
                for (int m = 0; m < 4; ++m)
#pragma unroll
                    for (int n = 0; n < 2; ++n) acc[a][b][m][n] = (f32x4){0.f, 0.f, 0.f, 0.f};
        cur = nxt; cA = nA; cB = nB; ++ui;
        if constexpr (ALIGN_EPI) { if (wr == 1) PG8_BAR; }
    }
    PG8_WAIT_V(0);
    if constexpr (!ALIGN_EPI) { if (wr == 0) PG8_BAR; }
    PG8_BAR;
    if constexpr (Epi::AFTER_DRAIN) { E.fused(acc, cur, wr, wc, fr, fq, lds, wid, lane); S.done(cur); }
#undef PG8_SA
#undef PG8_SB
#undef PG8_STAGE
#undef PG8_LDA
#undef PG8_LDB
#undef PG8_MMA
#undef PG8_WAIT_V
#undef PG8_WAIT_L
#undef PG8_BAR
#undef PG8_SCHED
}
}
#define LAS __attribute__((address_space(3)))
#define GAS __attribute__((address_space(1)))
typedef unsigned short bf16;
typedef float f32x4 __attribute__((ext_vector_type(4)));
typedef unsigned u32x4 __attribute__((ext_vector_type(4)));
typedef unsigned u32x2 __attribute__((ext_vector_type(2)));
typedef short bf16x8 __attribute__((ext_vector_type(8)));
constexpr int NWAVES = 8, NTHR = 512;
constexpr int DM = 2048, MP = 8192, MS = 512, MT = 8704, SEQ = 2048;
constexpr int NCP = 5376, RC = 1696, C_S = 1696, C_H = 2720, C_P = 4768;
constexpr int DFF = 5632, PLED = 256;
constexpr int LDS_BYTES = 147456;
constexpr int NPH = 24;
constexpr size_t WL_BYTES = 109051904;
constexpr size_t WO_IN = 0, WO_OUT = 22020096, WO_GU = 30408704, WO_DN = 76546048, WO_GT = 99614720, WO_PL = 108003328;
constexpr size_t WS_PB = 2 * WL_BYTES;
constexpr size_t WS_XN = WS_PB + (size_t)2 * MT * 256 * 2;
constexpr size_t WS_A = WS_XN + (size_t)MT * 2048 * 2;
constexpr size_t WS_MIX = WS_A + (size_t)MT * DFF * 2;
constexpr size_t SZ = (size_t)MT * 512;
constexpr size_t WS_B = WS_A + (size_t)MT * NCP * 4;
constexpr size_t WS_PLE = WS_B, WS_XF = WS_B + (size_t)MT * 2048 * 4;
constexpr size_t WS_C = WS_XF + (size_t)MT * 2048 * 4;
constexpr size_t WS_CTL = WS_C + 7 * SZ * 4, CTL_BYTES = 16384;
constexpr size_t WS_END = WS_CTL + CTL_BYTES;
static_assert(WS_MIX + (size_t)MT * 2048 * 4 <= WS_B, "ws map A");
static_assert(7 * SZ * 4 + (size_t)MT * 8 * 4 <= (size_t)2 * MT * 2048 * 4, "ws map B");
static_assert(WS_END <= 738197504ull, "ws map end");
constexpr size_t O_Y = 0, O_WKV_P = 17825792, O_SH_P = 18087936, O_HG_P = 18101504, O_PL_P = 18625792, O_WKV_S = 18687232, O_SH_S = 27075840, O_HG_S = 27510016, O_PL_S = 44287232, O_SGV = 46253312;

struct Args { const float* in[38]; float* out; unsigned char* ws; int ph_lo, ph_hi; };
struct ArgsD { const GAS float* in[38]; GAS float* out; GAS unsigned char* ws; int ph_lo, ph_hi; };

typedef const __attribute__((address_space(4))) ArgsD* ArgP;
__device__ __forceinline__ ArgP largs() { ArgP p = (ArgP)__builtin_amdgcn_kernarg_segment_ptr(); asm volatile("" : "+s"(p)); return p; }
__device__ __forceinline__ unsigned pk2(float lo, float hi) { return pg8::cvt_pk_bf16(lo, hi); }
__device__ __forceinline__ bf16 bf1(float v) { return (bf16)(pg8::cvt_pk_bf16(v, 0.f) & 0xffffu); }
__device__ __forceinline__ float sigm(float x) { return 1.0f / (1.0f + __expf(-x)); }
__device__ __forceinline__ float gelu_erf(float x) { return 0.5f * x * (1.0f + erff(x * 0.70710678118f)); }
template <int CTRL> __device__ __forceinline__ float dpp_f(float v) { return __builtin_bit_cast(float, __builtin_amdgcn_update_dpp(0, __builtin_bit_cast(int, v), CTRL, 0xF, 0xF, true)); }
__device__ __forceinline__ float red8(float v) { v += dpp_f<0xB1>(v); v += dpp_f<0x4E>(v); v += dpp_f<0x141>(v); return v; }
__device__ __forceinline__ float red16(float v) { v = red8(v); v += dpp_f<0x140>(v); return v; }
__device__ __forceinline__ bf16x8 pack8(const float (&t)[8]) { u32x4 w; w.x = pk2(t[0], t[1]); w.y = pk2(t[2], t[3]); w.z = pk2(t[4], t[5]); w.w = pk2(t[6], t[7]); return __builtin_bit_cast(bf16x8, w); }
__device__ __forceinline__ float rdlane(float v, int l) { return __builtin_bit_cast(float, __builtin_amdgcn_readlane(__builtin_bit_cast(int, v), l)); }
__device__ __forceinline__ float wave_sum(float v) { v = red16(v); return (rdlane(v, 0) + rdlane(v, 16)) + (rdlane(v, 32) + rdlane(v, 48)); }
#define LDS_WAIT() asm volatile("s_waitcnt lgkmcnt(0)" ::: "memory")

#define XB_TMO      128
#define XB_XCNT(j)  (256  + 64 * (j))
#define XB_XSUB(j)  (1280 + 64 * (j))
#define XB_XGEN(j)  (2304 + 64 * (j))
#define XB_TOP      3328
#define XB_TOPGEN   3392
#define XCD_BAR_WORDS 3456
#define XB_SPIN_CAP (1u << 18)

__device__ __forceinline__ unsigned xb_ld(unsigned* p)              { return __hip_atomic_load(p, __ATOMIC_RELAXED, __HIP_MEMORY_SCOPE_AGENT); }
__device__ __forceinline__ unsigned xb_add(unsigned* p, unsigned v) { return __hip_atomic_fetch_add(p, v, __ATOMIC_RELAXED, __HIP_MEMORY_SCOPE_AGENT); }
__device__ __forceinline__ unsigned xb_xcc_id() { return (unsigned)__builtin_amdgcn_s_getreg((3 << 11) | 20) & 0xFu; }
#define XB_SPIN(cond, bar) do { unsigned _sp = 0; while (cond) { __builtin_amdgcn_s_sleep(0); \
    if ((++_sp & 255u) == 0u) { if (xb_ld(&(bar)[XB_TMO])) break; if (_sp > XB_SPIN_CAP) { atomicAdd(&(bar)[XB_TMO], 1u); break; } } } } while (0)

struct XcdBarrier {
    unsigned* bar; unsigned x;
    volatile LAS unsigned* st;
};

__device__ __forceinline__ XcdBarrier xcd_barrier_post(unsigned* bar, volatile LAS unsigned* st) {
    XcdBarrier b; b.bar = bar; b.x = xb_xcc_id(); b.st = st;
    if (threadIdx.x == 0) (void)xb_add(&bar[XB_XCNT(b.x)], 1u);
    return b;
}
__device__ __forceinline__ void xcd_barrier_complete(unsigned* bar, unsigned x, unsigned& nloc, unsigned& nx) {
    const unsigned G = gridDim.x * gridDim.y * gridDim.z;
    unsigned sum, cnt, mine, sp = 0u;
    for (;;) {
        sum = 0u; cnt = 0u; mine = 0u;
#pragma unroll
        for (unsigned j = 0; j < 16; ++j) { const unsigned c = xb_ld(&bar[XB_XCNT(j)]); sum += c; cnt += (c > 0u) ? 1u : 0u; mine = (j == x) ? c : mine; }
        if (sum == G) break;
        __builtin_amdgcn_s_sleep(1);
        if ((++sp & 255u) == 0u) { if (xb_ld(&bar[XB_TMO])) break; if (sp > XB_SPIN_CAP) { atomicAdd(&bar[XB_TMO], 1u); break; } }
    }
    nloc = mine > 0u ? mine : 1u; nx = cnt > 0u ? cnt : 1u;
}

__device__ __forceinline__ void xcd_barrier(const XcdBarrier& b) {
    asm volatile("s_waitcnt vmcnt(0)" ::: "memory");
    __syncthreads();
    if (threadIdx.x == 0) {
        unsigned* bar = b.bar;
        __builtin_amdgcn_s_waitcnt(0);
        unsigned nloc = b.st[0], nx = b.st[1];
        if (nloc == 0u) { xcd_barrier_complete(bar, b.x, nloc, nx); b.st[0] = nloc; b.st[1] = nx; }
        const unsigned old = xb_add(&bar[XB_XSUB(b.x)], 1u);
        const unsigned gen = old / nloc;
        if (old + 1u == (gen + 1u) * nloc) {
            __builtin_amdgcn_fence(__ATOMIC_RELEASE, "agent");
            asm volatile("s_waitcnt vmcnt(0)" ::: "memory");
            const unsigned og = xb_add(&bar[XB_TOP], 1u);
            const unsigned tg = og / nx;
            if (og + 1u == (tg + 1u) * nx) xb_add(&bar[XB_TOPGEN], 1u);
            else XB_SPIN(xb_ld(&bar[XB_TOPGEN]) == tg, bar);
            __builtin_amdgcn_fence(__ATOMIC_ACQUIRE, "agent");
            xb_add(&bar[XB_XGEN(b.x)], 1u);
            asm volatile("s_waitcnt vmcnt(0)" ::: "memory");
        } else {
            XB_SPIN(xb_ld(&bar[XB_XGEN(b.x)]) == gen, bar);
            __builtin_amdgcn_fence(__ATOMIC_ACQUIRE, "agent");
            asm volatile("s_waitcnt vmcnt(0)" ::: "memory");
        }
    }
    __syncthreads();
}

__device__ __forceinline__ const GAS float* xrow(ArgP A, int layer, int m) {
    if (layer > 0) return A->out + (size_t)m * DM;
    return (m < MP) ? A->in[0] + (size_t)m * DM : A->in[1] + (size_t)(m - MP) * DM;
}
__device__ __forceinline__ const GAS float* prev_row(const GAS float* Z, const GAS float* shift_st, int m, float& mask) {
    mask = 1.f;
    if (m < MP) { if ((m & (SEQ - 1)) == 0) { mask = 0.f; return Z + (size_t)m * NCP; } return Z + (size_t)(m - 1) * NCP; }
    const int s = m - MP; if ((s & 3) == 0) return shift_st + (size_t)(s >> 2) * RC; return Z + (size_t)(m - 1) * NCP;
}
__device__ __forceinline__ void zm8(const GAS float* zr, const GAS float* pr, float msk, const GAS float* mu, int col, float (&o)[8]) {
    const f32x4 z0 = *(const GAS f32x4*)(zr + col), z1 = *(const GAS f32x4*)(zr + col + 4), p0 = *(const GAS f32x4*)(pr + col), p1 = *(const GAS f32x4*)(pr + col + 4), u0 = *(const GAS f32x4*)(mu + col), u1 = *(const GAS f32x4*)(mu + col + 4);
#pragma unroll
    for (int i = 0; i < 4; ++i) { o[i] = z0[i] + u0[i] * (p0[i] * msk - z0[i]); o[4 + i] = z1[i] + u1[i] * (p1[i] * msk - z1[i]); }
}

__device__ __forceinline__ void p0_transpose_item(const GAS float* W, int K, int N, GAS bf16* WT, int mode, LAS float* scr, int item, int lane) {
    const int nblk = N / 32, kb = item / nblk, nb = item % nblk, k0 = 64 * kb, n0 = 32 * nb;
    int r0 = n0;
    if (mode & 1) { r0 = (n0 < DFF) ? (n0 / 128) * 256 + (n0 % 128) : ((n0 - DFF) / 128) * 256 + 128 + ((n0 - DFF) % 128); }
    float tv[32];
#pragma unroll
    for (int i = 0; i < 32; ++i) tv[i] = __builtin_nontemporal_load(&W[(size_t)(k0 + 2 * i + (lane >> 5)) * N + n0 + (lane & 31)]);
#pragma unroll
    for (int i = 0; i < 32; ++i) scr[(2 * i + (lane >> 5)) * 33 + (lane & 31)] = tv[i];
    LDS_WAIT();
    const int c = lane & 7;
#pragma unroll
    for (int j = 0; j < 4; ++j) { const int n = (lane >> 3) + 8 * j; const LAS float* s = scr + (8 * c) * 33 + n;
        u32x4 o; o.x = pk2(s[0 * 33], s[1 * 33]); o.y = pk2(s[2 * 33], s[3 * 33]); o.z = pk2(s[4 * 33], s[5 * 33]); o.w = pk2(s[6 * 33], s[7 * 33]);
        if (mode & 2) __builtin_nontemporal_store(o, (GAS u32x4*)(WT + (size_t)(r0 + n) * K + k0 + 8 * c)); else *(GAS u32x4*)(WT + (size_t)(r0 + n) * K + k0 + 8 * c) = o; }
    LDS_WAIT();
}
template <bool NT = false> __device__ __forceinline__ void row_rms_bf16(const GAS float* x, const GAS float* g, GAS bf16* o, int lane) {
    f32x4 v[8]; float s = 0.f;
#pragma unroll
    for (int j = 0; j < 8; ++j) { v[j] = NT ? __builtin_nontemporal_load(&((const GAS f32x4*)x)[64 * j + lane]) : ((const GAS f32x4*)x)[64 * j + lane]; s += (v[j].x * v[j].x + v[j].y * v[j].y) + (v[j].z * v[j].z + v[j].w * v[j].w); }
    const float r = rsqrtf(wave_sum(s) * (1.0f / DM) + 1e-6f);
#pragma unroll
    for (int j = 0; j < 8; ++j) { const f32x4 gg = ((const GAS f32x4*)g)[64 * j + lane]; u32x2 w; w.x = pk2(v[j].x * r * gg.x, v[j].y * r * gg.y); w.y = pk2(v[j].z * r * gg.z, v[j].w * r * gg.w); ((GAS u32x2*)o)[64 * j + lane] = w; }
}
__device__ __forceinline__ void p0_prologue(ArgP A, LAS unsigned char* lds, int tid, int lane, int wave, int bid, int G) {
    LAS float* scr = (LAS float*)(lds + wave * 16384);
    const int gw = bid * NWAVES + wave, NGW = G * NWAVES;
    constexpr int I_IN = 32 * 165, I_OUT = 32 * 64, I_GU = 32 * 352, I_DN = 88 * 64, I_GT = 32 * 64, I_PL = 4 * 64, I_L = I_IN + I_OUT + I_GU + I_DN + I_GT + I_PL;
    for (int it = gw; it < 2 * I_L; it += NGW) {
        const int layer = it / I_L; int r = it - layer * I_L;
        GAS unsigned char* wb = A->ws + (size_t)layer * WL_BYTES;
        if (r < I_IN) { p0_transpose_item(A->in[12] + (size_t)layer * DM * 5280, DM, 5280, (GAS bf16*)(wb + WO_IN), 0 | (layer ? 2 : 0), scr, r, lane); continue; } r -= I_IN;
        if (r < I_OUT) { p0_transpose_item(A->in[33] + (size_t)layer * DM * DM, DM, DM, (GAS bf16*)(wb + WO_OUT), 0 | (layer ? 2 : 0), scr, r, lane); continue; } r -= I_OUT;
        if (r < I_GU) { p0_transpose_item(A->in[34] + (size_t)layer * DM * 2 * DFF, DM, 2 * DFF, (GAS bf16*)(wb + WO_GU), 1 | (layer ? 2 : 0), scr, r, lane); continue; } r -= I_GU;
        if (r < I_DN) { p0_transpose_item(A->in[35] + (size_t)layer * DFF * DM, DFF, DM, (GAS bf16*)(wb + WO_DN), 0 | (layer ? 2 : 0), scr, r, lane); continue; } r -= I_DN;
        if (r < I_GT) { p0_transpose_item(A->in[36] + (size_t)layer * DM * DM, DM, DM, (GAS bf16*)(wb + WO_GT), 0 | (layer ? 2 : 0), scr, r, lane); continue; } r -= I_GT;
        p0_transpose_item(A->in[37] + (size_t)layer * PLED * DM, PLED, DM, (GAS bf16*)(wb + WO_PL), 0 | (layer ? 2 : 0), scr, r, lane);
    }
    const int gt = bid * NTHR + tid, NGT = G * NTHR;
    for (int i = gt; i < 2 * 96 * 256; i += NGT) { const int layer = i / (96 * 256), r = i % (96 * 256); ((GAS u32x4*)(A->ws + (size_t)layer * WL_BYTES + WO_IN + (size_t)5280 * DM * 2))[r] = (u32x4){0u, 0u, 0u, 0u}; }
    for (int i = gt; i < 2 * MT * 64; i += NGT) { const int layer = i / (MT * 64), rem = i % (MT * 64), m = rem >> 6, c4 = rem & 63;
        const GAS float* src = (m < MP) ? A->in[6] + ((size_t)layer * MP + m) * PLED : A->in[7] + ((size_t)layer * MS + (m - MP)) * PLED;
        const f32x4 v = __builtin_nontemporal_load(&((const GAS f32x4*)src)[c4]); u32x2 w; w.x = pk2(v.x, v.y); w.y = pk2(v.z, v.w); ((GAS u32x2*)(A->ws + WS_PB))[i] = w; }
    for (int m = gw; m < MT; m += NGW) row_rms_bf16<true>(xrow(A, 0, m), A->in[8], (GAS bf16*)(A->ws + WS_XN) + (size_t)m * DM, lane);
}

__device__ __forceinline__ void part_sum(const GAS unsigned char* ws, int m, int ns, int lane, f32x4 (&v)[8]) {
    const GAS f32x4* p = (const GAS f32x4*)(ws + WS_C) + (size_t)(m - MP) * (DM / 4);
#pragma unroll
    for (int j = 0; j < 8; ++j) v[j] = p[64 * j + lane];
#pragma unroll 1
    for (int s = 1; s < ns; ++s) { p += (size_t)MS * (DM / 4); asm volatile("" : "+v"(p));
#pragma unroll
        for (int j = 0; j < 8; ++j) v[j] += p[64 * j + lane]; }
}
__device__ __forceinline__ void sample_gate_row(ArgP A, int m, int lane, f32x4 (&v)[8]) {
    part_sum(A->ws, m, 8, lane, v);
    const GAS f32x4* xf = (const GAS f32x4*)(A->ws + WS_XF) + (size_t)m * (DM / 4); const GAS f32x4* pl = (const GAS f32x4*)(A->ws + WS_PLE) + (size_t)m * (DM / 4);
#pragma unroll
    for (int j = 0; j < 8; ++j) { const f32x4 x = xf[64 * j + lane], q = pl[64 * j + lane]; f32x4 o;
#pragma unroll
        for (int e = 0; e < 4; ++e) o[e] = x[e] + q[e] * sigm(v[j][e]);
        v[j] = o; }
}
__device__ __forceinline__ void final_phase(ArgP A, int lane, int wave, int bid, int G) {
    for (int m = MP + bid * NWAVES + wave; m < MT; m += G * NWAVES) { f32x4 v[8]; sample_gate_row(A, m, lane, v); GAS f32x4* o = (GAS f32x4*)(A->out + O_Y) + (size_t)m * (DM / 4);
#pragma unroll
        for (int j = 0; j < 8; ++j) o[64 * j + lane] = v[j]; }
}
__device__ __forceinline__ int row_of(int gw, int NW, int i) {
    if (NW != 2048) { const int m = gw + i * NW; return m < MT ? m : -1; }
    if (gw < MS) return i == 0 ? MP + gw : (i == 1 ? gw : -1);
    return i < 5 ? MS + (gw - MS) + 1536 * i : -1;
}
__device__ __forceinline__ void rowA_phase(ArgP A, int layer, int lane, int wave, int bid, int G) {
    const int gw_ = bid * NWAVES + wave, NW_ = G * NWAVES;
    for (int ri = 0, m = row_of(gw_, NW_, 0); m >= 0; m = row_of(gw_, NW_, ++ri)) {
        if (m >= MP) { f32x4 v[8]; sample_gate_row(A, m, lane, v); GAS f32x4* o = (GAS f32x4*)(A->out + O_Y) + (size_t)m * (DM / 4); float s = 0.f;
#pragma unroll
            for (int j = 0; j < 8; ++j) { o[64 * j + lane] = v[j]; s += (v[j].x * v[j].x + v[j].y * v[j].y) + (v[j].z * v[j].z + v[j].w * v[j].w); }
            const float r = rsqrtf(wave_sum(s) * (1.0f / DM) + 1e-6f); const GAS float* g = A->in[8] + layer * DM; GAS u32x2* xn = (GAS u32x2*)(A->ws + WS_XN) + (size_t)m * (DM / 4);
#pragma unroll
            for (int j = 0; j < 8; ++j) { const f32x4 gg = ((const GAS f32x4*)g)[64 * j + lane]; u32x2 w; w.x = pk2(v[j].x * r * gg.x, v[j].y * r * gg.y); w.y = pk2(v[j].z * r * gg.z, v[j].w * r * gg.w); xn[64 * j + lane] = w; }
        } else row_rms_bf16(xrow(A, layer, m), A->in[8] + layer * DM, (GAS bf16*)(A->ws + WS_XN) + (size_t)m * DM, lane);
    }
}
__device__ __forceinline__ void rowB_phase(ArgP A, int layer, int lane, int wave, int bid, int G) {
    const GAS float* gpost = A->in[9] + layer * DM; const GAS float* gpre = A->in[10] + layer * DM;
    const int gw_ = bid * NWAVES + wave, NW_ = G * NWAVES; int ri = 0; int m = row_of(gw_, NW_, 0);
    f32x4 xv[8], mv[8];
#define ROWB_LOAD(mm, X, M_) do { const GAS f32x4* x_ = (const GAS f32x4*)xrow(A, layer, (mm)); const GAS f32x4* mx_ = (const GAS f32x4*)(A->ws + WS_MIX) + (size_t)(mm) * (DM / 4); \
        _Pragma("unroll") for (int j = 0; j < 8; ++j) { X[j] = __builtin_nontemporal_load(&x_[64 * j + lane]); if ((mm) < MP) M_[j] = __builtin_nontemporal_load(&mx_[64 * j + lane]); } } while (0)
    if (m >= 0) ROWB_LOAD(m, xv, mv);
    while (m >= 0) {
        const int mn = row_of(gw_, NW_, ++ri); f32x4 xn2[8], mn2[8];
        if (mn >= 0) ROWB_LOAD(mn, xn2, mn2);
        if (m >= MP) part_sum(A->ws, m, 8, lane, mv);
        float s = 0.f;
#pragma unroll
        for (int j = 0; j < 8; ++j) s += (mv[j].x * mv[j].x + mv[j].y * mv[j].y) + (mv[j].z * mv[j].z + mv[j].w * mv[j].w);
        const float r1 = rsqrtf(wave_sum(s) * (1.0f / DM) + 1e-6f); float s2 = 0.f;
#pragma unroll
        for (int j = 0; j < 8; ++j) { const f32x4 g = ((const GAS f32x4*)gpost)[64 * j + lane]; xv[j] = xv[j] + mv[j] * r1 * g; s2 += (xv[j].x * xv[j].x + xv[j].y * xv[j].y) + (xv[j].z * xv[j].z + xv[j].w * xv[j].w); }
        const float r2 = rsqrtf(wave_sum(s2) * (1.0f / DM) + 1e-6f);
        GAS f32x4* xf = (GAS f32x4*)(A->ws + WS_XF) + (size_t)m * (DM / 4); GAS u32x2* xn = (GAS u32x2*)(A->ws + WS_XN) + (size_t)m * (DM / 4);
#pragma unroll
        for (int j = 0; j < 8; ++j) { const f32x4 g = ((const GAS f32x4*)gpre)[64 * j + lane]; xf[64 * j + lane] = xv[j];
            u32x2 w; w.x = pk2(xv[j].x * r2 * g.x, xv[j].y * r2 * g.y); w.y = pk2(xv[j].z * r2 * g.z, xv[j].w * r2 * g.w); xn[64 * j + lane] = w; }
#pragma unroll
        for (int j = 0; j < 8; ++j) { xv[j] = xn2[j]; mv[j] = mn2[j]; }
        m = mn;
    }
#undef ROWB_LOAD
}
__device__ __forceinline__ void rowC_phase(ArgP A, int layer, int lane, int wave, int bid, int G) {
    const GAS float* gpost = A->in[11] + layer * DM;
    const int gw_ = bid * NWAVES + wave, NW_ = G * NWAVES; int ri = 0; int m = row_of(gw_, NW_, 0);
    f32x4 xv[8], mv[8];
#define ROWC_LOAD(mm, X, M_) do { const GAS f32x4* x_ = (const GAS f32x4*)(A->ws + WS_XF) + (size_t)(mm) * (DM / 4); const GAS f32x4* mx_ = (const GAS f32x4*)(A->ws + WS_MIX) + (size_t)(mm) * (DM / 4); \
        _Pragma("unroll") for (int j = 0; j < 8; ++j) { X[j] = __builtin_nontemporal_load(&x_[64 * j + lane]); if ((mm) < MP) M_[j] = __builtin_nontemporal_load(&mx_[64 * j + lane]); } } while (0)
    if (m >= 0) ROWC_LOAD(m, xv, mv);
    while (m >= 0) {
        const int mn = row_of(gw_, NW_, ++ri); f32x4 xn2[8], mn2[8];
        if (mn >= 0) ROWC_LOAD(mn, xn2, mn2);
        if (m >= MP) part_sum(A->ws, m, 11, lane, mv);
        float s = 0.f;
#pragma unroll
        for (int j = 0; j < 8; ++j) s += (mv[j].x * mv[j].x + mv[j].y * mv[j].y) + (mv[j].z * mv[j].z + mv[j].w * mv[j].w);
        const float r1 = rsqrtf(wave_sum(s) * (1.0f / DM) + 1e-6f);
        GAS f32x4* xf = (GAS f32x4*)(A->ws + WS_XF) + (size_t)m * (DM / 4); GAS u32x2* xn = (GAS u32x2*)(A->ws + WS_XN) + (size_t)m * (DM / 4);
#pragma unroll
        for (int j = 0; j < 8; ++j) { const f32x4 g = ((const GAS f32x4*)gpost)[64 * j + lane]; const f32x4 o = xv[j] + mv[j] * r1 * g; xf[64 * j + lane] = o;
            u32x2 w; w.x = pk2(o.x, o.y); w.y = pk2(o.z, o.w); xn[64 * j + lane] = w; }
#pragma unroll
        for (int j = 0; j < 8; ++j) { xv[j] = xn2[j]; mv[j] = mn2[j]; }
        m = mn;
    }
#undef ROWC_LOAD
}
__device__ __forceinline__ void m1_phase(ArgP A, int layer, LAS unsigned char* lds, int tid, int lane, int wave, int bid, int G) {
    const GAS float* Z = (const GAS float*)(A->ws + WS_A);
    GAS float* RW = (GAS float*)(A->ws + WS_B); GAS float* RK = RW + 7 * SZ;
    GAS float* U = (GAS float*)(A->ws + WS_C) + SZ; GAS float* VLN = U + SZ;
    const GAS float* mu = A->in[13] + layer * RC; const GAS float* wl = A->in[14] + layer * 32 * 512; const GAS float* w0 = A->in[15] + layer * 512;
    const GAS float* al = A->in[16] + layer * 32 * 512; const GAS float* a0 = A->in[17] + layer * 512; const GAS float* gl = A->in[18] + layer * 96 * 512;
    const GAS float* kk_ = A->in[19] + layer * 512; const GAS float* ka_ = A->in[20] + layer * 512; const GAS float* rk_ = A->in[21] + layer * 512;
    const GAS float* lnw = A->in[24] + layer * 512; const GAS float* lnb = A->in[25] + layer * 512;
    const GAS float* shift_st = A->in[3] + (size_t)layer * 128 * RC;
    const int c = lane & 15, quad = lane >> 4, h = wave;
    LAS float* part = (LAS float*)(lds + 131072);
    LAS unsigned char* fr = lds + wave * 16384 + lane * 16;
    bf16x8 bw[4];
#pragma unroll
    for (int ct = 0; ct < 4; ++ct) { const int n = h * 64 + ct * 16 + c; float tb[8];
#pragma unroll
        for (int j = 0; j < 8; ++j) tb[j] = wl[(quad * 8 + j) * 512 + n];
        bw[ct] = pack8(tb);
#pragma unroll
        for (int j = 0; j < 8; ++j) tb[j] = al[(quad * 8 + j) * 512 + n];
        *(LAS bf16x8*)(fr + ct * 1024) = pack8(tb);
#pragma unroll
        for (int kk = 0; kk < 3; ++kk) {
#pragma unroll
            for (int j = 0; j < 8; ++j) tb[j] = gl[(kk * 32 + quad * 8 + j) * 512 + n];
            *(LAS bf16x8*)(fr + (4 + kk * 4 + ct) * 1024) = pack8(tb); } }
    LDS_WAIT();
    float p_mr[4], p_mk[4], p_mv[4], p_w0[4], p_a0[4], p_kk[4], p_ka[4], p_rk[4], p_lw[4], p_lb[4];
#pragma unroll
    for (int ct = 0; ct < 4; ++ct) { const int n = h * 64 + ct * 16 + c; p_mr[ct] = mu[n]; p_mk[ct] = mu[512 + n]; p_mv[ct] = mu[1024 + n]; p_w0[ct] = w0[n]; p_a0[ct] = a0[n];
        p_kk[ct] = kk_[n]; p_ka[ct] = ka_[n]; p_rk[ct] = rk_[n]; p_lw[ct] = lnw[n]; p_lb[ct] = lnb[n]; }
    for (int unit = bid; unit < 512 + 64; unit += G) {
        const int tile = unit < 512 ? unit : 512 + ((unit - 512) >> 1); const int jlo = unit < 512 ? 0 : ((unit - 512) & 1) * 2, jhi = unit < 512 ? 4 : jlo + 2;
        const int m0 = tile * 16;
        f32x4 accw[4], acca[4], accg[4];
        {
            const int m = m0 + c; float msk; const GAS float* zr = Z + (size_t)m * NCP; const GAS float* pr = prev_row(Z, shift_st, m, msk);
            float t[8]; bf16x8 aw, aa, ag[3];
            zm8(zr, pr, msk, mu, 1536 + quad * 8, t);
#pragma unroll
            for (int j = 0; j < 8; ++j) t[j] = tanhf(t[j]);
            aw = pack8(t);
            zm8(zr, pr, msk, mu, 1568 + quad * 8, t); aa = pack8(t);
#pragma unroll
            for (int kk = 0; kk < 3; ++kk) { zm8(zr, pr, msk, mu, 1600 + kk * 32 + quad * 8, t);
#pragma unroll
                for (int j = 0; j < 8; ++j) t[j] = sigm(t[j]);
                ag[kk] = pack8(t); }
            const f32x4 zero = {0.f, 0.f, 0.f, 0.f};
#pragma unroll
            for (int ct = 0; ct < 4; ++ct) {
                accw[ct] = __builtin_amdgcn_mfma_f32_16x16x32_bf16(aw, bw[ct], zero, 0, 0, 0);
                acca[ct] = __builtin_amdgcn_mfma_f32_16x16x32_bf16(aa, *(const LAS bf16x8*)(fr + ct * 1024), zero, 0, 0, 0);
                accg[ct] = zero;
#pragma unroll
                for (int kk = 0; kk < 3; ++kk) accg[ct] = __builtin_amdgcn_mfma_f32_16x16x32_bf16(ag[kk], *(const LAS bf16x8*)(fr + (4 + kk * 4 + ct) * 1024), accg[ct], 0, 0, 0); }
        }
        float vg[4][4];
#pragma unroll
        for (int jj = 0; jj < 4; ++jj) {
            if (jj < jlo || jj >= jhi) continue;
            const int m = m0 + quad * 4 + jj; float msk; const GAS float* zr = Z + (size_t)m * NCP; const GAS float* pr = prev_row(Z, shift_st, m, msk);
            float r_[4], km[4], v_[4], wd[4], as[4], kkv[4]; float nsq = 0.f, rks = 0.f, s1 = 0.f, s2 = 0.f;
            float i_r[4], i_k[4], i_v[4], i_pr[4], i_pk[4], i_pv[4], i_su[4], i_sv[4];
#pragma unroll
            for (int ct = 0; ct < 4; ++ct) { const int n = h * 64 + ct * 16 + c; i_r[ct] = zr[n]; i_k[ct] = zr[512 + n]; i_v[ct] = zr[1024 + n]; i_pr[ct] = pr[n]; i_pk[ct] = pr[512 + n]; i_pv[ct] = pr[1024 + n];
                i_su[ct] = zr[C_S + n]; i_sv[ct] = zr[C_S + 512 + n]; }
            float gu[4];
#pragma unroll
            for (int ct = 0; ct < 4; ++ct) {
                const float zr_r = i_r[ct], zr_k = i_k[ct], zr_v = i_v[ct];
                r_[ct] = zr_r + p_mr[ct] * (i_pr[ct] * msk - zr_r);
                const float kraw = zr_k + p_mk[ct] * (i_pk[ct] * msk - zr_k);
                v_[ct] = zr_v + p_mv[ct] * (i_pv[ct] * msk - zr_v);
                wd[ct] = __expf(-0.6065306597f * sigm(p_w0[ct] + accw[ct][jj]));
                as[ct] = sigm(p_a0[ct] + acca[ct][jj]);
                kkv[ct] = kraw * p_kk[ct]; km[ct] = kraw * (1.0f + (as[ct] - 1.0f) * p_ka[ct]);
                nsq += kkv[ct] * kkv[ct]; rks += r_[ct] * km[ct] * p_rk[ct];
                gu[ct] = gelu_erf(i_su[ct]);
                const float gv = gelu_erf(i_sv[ct]); vg[jj][ct] = gv; s1 += gv; s2 += gv * gv; }
#pragma unroll
            for (int ct = 0; ct < 4; ++ct) U[(size_t)m * 512 + h * 64 + ct * 16 + c] = gu[ct];
            nsq = red16(nsq); rks = red16(rks); s1 = red16(s1); s2 = red16(s2);
            const float inv = 1.0f / fmaxf(sqrtf(nsq), 1e-12f);
#pragma unroll
            for (int ct = 0; ct < 4; ++ct) { const size_t o = (size_t)m * 512 + h * 64 + ct * 16 + c; const float kn = kkv[ct] * inv;
                RW[o] = r_[ct]; RW[SZ + o] = wd[ct]; RW[2 * SZ + o] = km[ct]; RW[3 * SZ + o] = v_[ct]; RW[4 * SZ + o] = -kn; RW[5 * SZ + o] = kn * as[ct]; RW[6 * SZ + o] = accg[ct][jj]; }
            if (c == 0) { RK[m * 8 + h] = rks; part[(wave * 16 + quad * 4 + jj) * 2] = s1; part[(wave * 16 + quad * 4 + jj) * 2 + 1] = s2; }
        }
        __syncthreads();
#pragma unroll
        for (int jj = 0; jj < 4; ++jj) {
            if (jj < jlo || jj >= jhi) continue;
            const int tk = quad * 4 + jj, m = m0 + tk; float S1 = 0.f, S2 = 0.f;
#pragma unroll
            for (int w = 0; w < 8; ++w) { S1 += part[(w * 16 + tk) * 2]; S2 += part[(w * 16 + tk) * 2 + 1]; }
            const float mean = S1 * (1.0f / 512.0f), var = fmaxf(S2 * (1.0f / 512.0f) - mean * mean, 0.f), rstd = rsqrtf(var + 1e-5f);
#pragma unroll
            for (int ct = 0; ct < 4; ++ct) { const int n = h * 64 + ct * 16 + c; const float vl = (vg[jj][ct] - mean) * rstd * p_lw[ct] + p_lb[ct];
                VLN[(size_t)m * 512 + n] = vl; if (m >= MP) A->out[O_SGV + ((size_t)layer * MS + (m - MP)) * 512 + n] = vl; }
        }
#pragma unroll
        for (int tk = 3; tk < 16; tk += 4) { const int m = m0 + tk;
            const bool last = (jhi < 4) ? false : (m < MP) ? ((m & (SEQ - 1)) == SEQ - 1) : (((m - MP) & 3) == 3);
            if (last) { GAS float* dst = (m < MP) ? A->out + O_SH_P + ((size_t)layer * 4 + (m >> 11)) * RC : A->out + O_SH_S + ((size_t)layer * 128 + ((m - MP) >> 2)) * RC;
                for (int cc = tid; cc < RC; cc += NTHR) dst[cc] = Z[(size_t)m * NCP + cc]; } }
        __syncthreads();
    }
}

__device__ __forceinline__ void rwkv_scan_rg(LAS float* buf, const GAS float* RW, int mbase, int nsteps, int h, int rg, const GAS float* Sinit, GAS float* Sout, GAS float* YR, int lane) {
    const int rl = lane >> 3, cgp = lane & 7;
    float S[8];
    if (Sinit) { const f32x4 s0 = *(const GAS f32x4*)(Sinit + (rg * 8 + rl) * 64 + cgp * 8), s1 = *(const GAS f32x4*)(Sinit + (rg * 8 + rl) * 64 + cgp * 8 + 4);
        S[0] = s0.x; S[1] = s0.y; S[2] = s0.z; S[3] = s0.w; S[4] = s1.x; S[5] = s1.y; S[6] = s1.z; S[7] = s1.w; }
    else {
#pragma unroll
        for (int i = 0; i < 8; ++i) S[i] = 0.f; }
    const GAS float* gp = RW + (size_t)mbase * 512 + h * 64 + lane;
    float pre[24];
#pragma unroll
    for (int s = 0; s < 4; ++s)
#pragma unroll
        for (int q = 0; q < 6; ++q) pre[s * 6 + q] = gp[(size_t)q * SZ + s * 512];
#pragma unroll
    for (int i = 0; i < 24; ++i) buf[i * 64 + lane] = pre[i];
    const int nch = nsteps >> 2;
    for (int ci = 0; ci < nch; ++ci) {
        const bool more = ci + 1 < nch;
        if (more) { const GAS float* g2 = gp + (size_t)(ci + 1) * 4 * 512;
#pragma unroll
            for (int s = 0; s < 4; ++s)
#pragma unroll
                for (int q = 0; q < 6; ++q) pre[s * 6 + q] = g2[(size_t)q * SZ + s * 512]; }
        LDS_WAIT();
        const LAS float* cb = buf + (ci & 1) * 1536;
#pragma unroll
        for (int s = 0; s < 4; ++s) { const LAS float* sb = cb + s * 384;
            const f32x4 r0 = *(const LAS f32x4*)(sb + cgp * 8), r1 = *(const LAS f32x4*)(sb + cgp * 8 + 4);
            const f32x4 w0 = *(const LAS f32x4*)(sb + 64 + cgp * 8), w1 = *(const LAS f32x4*)(sb + 64 + cgp * 8 + 4);
            const f32x4 k0 = *(const LAS f32x4*)(sb + 128 + cgp * 8), k1 = *(const LAS f32x4*)(sb + 128 + cgp * 8 + 4);
            const f32x4 a0 = *(const LAS f32x4*)(sb + 256 + cgp * 8), a1 = *(const LAS f32x4*)(sb + 256 + cgp * 8 + 4);
            const f32x4 b0 = *(const LAS f32x4*)(sb + 320 + cgp * 8), b1 = *(const LAS f32x4*)(sb + 320 + cgp * 8 + 4);
            const float vv = sb[192 + rg * 8 + rl];
            const float rr[8] = {r0.x, r0.y, r0.z, r0.w, r1.x, r1.y, r1.z, r1.w}, ww[8] = {w0.x, w0.y, w0.z, w0.w, w1.x, w1.y, w1.z, w1.w}, kx[8] = {k0.x, k0.y, k0.z, k0.w, k1.x, k1.y, k1.z, k1.w};
            const float ax[8] = {a0.x, a0.y, a0.z, a0.w, a1.x, a1.y, a1.z, a1.w}, bx[8] = {b0.x, b0.y, b0.z, b0.w, b1.x, b1.y, b1.z, b1.w};
            float sa = 0.f;
#pragma unroll
            for (int i = 0; i < 8; ++i) sa += S[i] * ax[i];
            sa = red8(sa);
            float y = 0.f;
#pragma unroll
            for (int i = 0; i < 8; ++i) { S[i] = S[i] * ww[i] + (sa * bx[i] + vv * kx[i]); y += S[i] * rr[i]; }
            y = red8(y);
            if (cgp == 0) YR[(size_t)(mbase + ci * 4 + s) * 512 + h * 64 + rg * 8 + rl] = y;
        }
        if (more) { LAS float* nb = buf + ((ci + 1) & 1) * 1536;
#pragma unroll
            for (int i = 0; i < 24; ++i) nb[i * 64 + lane] = pre[i]; }
    }
    GAS float* so = Sout + (rg * 8 + rl) * 64 + cgp * 8;
    *(GAS f32x4*)so = (f32x4){S[0], S[1], S[2], S[3]}; *(GAS f32x4*)(so + 4) = (f32x4){S[4], S[5], S[6], S[7]};
}
__device__ __forceinline__ void rwkv_sample_wave(LAS float* buf, const GAS float* RW, int mbase, int h, const GAS float* Sinit, GAS float* Sout, GAS float* YR, int lane) {
    const int rl = lane >> 3, cgp = lane & 7;
    const GAS float* gp = RW + (size_t)mbase * 512 + h * 64 + lane;
    float pre[24];
#pragma unroll
    for (int s = 0; s < 4; ++s)
#pragma unroll
        for (int q = 0; q < 6; ++q) pre[s * 6 + q] = gp[(size_t)q * SZ + s * 512];
    f32x4 n0 = __builtin_nontemporal_load((const GAS f32x4*)(Sinit + rl * 64 + cgp * 8)), n1 = __builtin_nontemporal_load((const GAS f32x4*)(Sinit + rl * 64 + cgp * 8 + 4));
#pragma unroll
    for (int i = 0; i < 24; ++i) buf[i * 64 + lane] = pre[i];
    LDS_WAIT();
    for (int rg = 0; rg < 8; ++rg) {
        float S[8] = {n0.x, n0.y, n0.z, n0.w, n1.x, n1.y, n1.z, n1.w};
        if (rg + 1 < 8) { n0 = __builtin_nontemporal_load((const GAS f32x4*)(Sinit + ((rg + 1) * 8 + rl) * 64 + cgp * 8)); n1 = __builtin_nontemporal_load((const GAS f32x4*)(Sinit + ((rg + 1) * 8 + rl) * 64 + cgp * 8 + 4)); }
#pragma unroll
        for (int s = 0; s < 4; ++s) { const LAS float* sb = buf + s * 384;
            const f32x4 r0 = *(const LAS f32x4*)(sb + cgp * 8), r1 = *(const LAS f32x4*)(sb + cgp * 8 + 4), w0 = *(const LAS f32x4*)(sb + 64 + cgp * 8), w1 = *(const LAS f32x4*)(sb + 64 + cgp * 8 + 4);
            const f32x4 k0 = *(const LAS f32x4*)(sb + 128 + cgp * 8), k1 = *(const LAS f32x4*)(sb + 128 + cgp * 8 + 4), a0 = *(const LAS f32x4*)(sb + 256 + cgp * 8), a1 = *(const LAS f32x4*)(sb + 256 + cgp * 8 + 4);
            const f32x4 b0 = *(const LAS f32x4*)(sb + 320 + cgp * 8), b1 = *(const LAS f32x4*)(sb + 320 + cgp * 8 + 4);
            const float vv = sb[192 + rg * 8 + rl];
            const float rr[8] = {r0.x, r0.y, r0.z, r0.w, r1.x, r1.y, r1.z, r1.w}, ww[8] = {w0.x, w0.y, w0.z, w0.w, w1.x, w1.y, w1.z, w1.w}, kx[8] = {k0.x, k0.y, k0.z, k0.w, k1.x, k1.y, k1.z, k1.w};
            const float ax[8] = {a0.x, a0.y, a0.z, a0.w, a1.x, a1.y, a1.z, a1.w}, bx[8] = {b0.x, b0.y, b0.z, b0.w, b1.x, b1.y, b1.z, b1.w};
            float sa = 0.f;
#pragma unroll
            for (int i = 0; i < 8; ++i) sa += S[i] * ax[i];
            sa = red8(sa);
            float y = 0.f;
#pragma unroll
            for (int i = 0; i < 8; ++i) { S[i] = S[i] * ww[i] + (sa * bx[i] + vv * kx[i]); y += S[i] * rr[i]; }
            y = red8(y);
            if (cgp == 0) YR[(size_t)(mbase + s) * 512 + h * 64 + rg * 8 + rl] = y; }
        GAS float* so = Sout + (rg * 8 + rl) * 64 + cgp * 8;
        __builtin_nontemporal_store((f32x4){S[0], S[1], S[2], S[3]}, (GAS f32x4*)so); __builtin_nontemporal_store((f32x4){S[4], S[5], S[6], S[7]}, (GAS f32x4*)(so + 4));
    }
    LDS_WAIT();
}
__device__ __forceinline__ float hgrn_lb(const GAS float* logits, int layer, int cfull) {
    if (layer == 0) return 0.f;
    return 1.0f / (1.0f + __expf(logits[cfull] - logits[512 + cfull]));
}
__device__ __forceinline__ void hgrn_prompt_job(LAS unsigned char* lds, const GAS float* Z, const GAS float* logits, int layer, int b, int h, int dq, GAS float* OP, GAS float* Sout, int tid, int lane, int wave) {
    LAS float* OPS = (LAS float*)lds;
    LAS float* VV = (LAS float*)(lds + 12288);
    LAS float* OPL = (LAS float*)(lds + 28672);
    const int st = tid >> 5, sd = tid & 31, cfull = h * 128 + dq * 32 + sd;
    const float lb = hgrn_lb(logits, layer, cfull);
    const int mbase = b * SEQ;
    const GAS float* zq = Z + (size_t)mbase * NCP + C_H + cfull; const GAS float* zf = zq + 512; const GAS float* zv = Z + (size_t)mbase * NCP + C_H + 1024 + h * 128;
    const int slot = (st * 4 + (sd >> 3)) * 24 + (sd & 7);
    {   const float f = zf[(size_t)st * NCP], q = zq[(size_t)st * NCP], fg = lb + (1.0f - lb) * sigm(f);
        OPS[slot] = fg; OPS[slot + 8] = 1.0f - fg; OPS[slot + 16] = q * sigm(q);
#pragma unroll
        for (int i = 0; i < 4; ++i) { const int idx = tid + 512 * i; VV[idx] = zv[(size_t)(idx >> 7) * NCP + (idx & 127)]; } }
    __syncthreads();
    float S[8][2];
#pragma unroll
    for (int d = 0; d < 8; ++d) { S[d][0] = 0.f; S[d][1] = 0.f; }
    for (int ci = 0; ci < SEQ / 16; ++ci) {
        const bool more = ci + 1 < SEQ / 16; float pf = 0.f, pq = 0.f, pv[4] = {0.f, 0.f, 0.f, 0.f};
        if (more) { const size_t row = (size_t)(ci + 1) * 16; pf = zf[(row + st) * NCP]; pq = zq[(row + st) * NCP];
#pragma unroll
            for (int i = 0; i < 4; ++i) { const int idx = tid + 512 * i; pv[i] = zv[(row + (idx >> 7)) * NCP + (idx & 127)]; } }
        if (wave < 4) {
            const LAS float* co = OPS + (ci & 1) * 1536; const LAS float* cv = VV + (ci & 1) * 2048;
#pragma unroll 4
            for (int t = 0; t < 16; ++t) { const LAS float* ob = co + (t * 4 + wave) * 24;
                const f32x4 F0 = *(const LAS f32x4*)ob, F1 = *(const LAS f32x4*)(ob + 4), K0 = *(const LAS f32x4*)(ob + 8), K1 = *(const LAS f32x4*)(ob + 12), Q0 = *(const LAS f32x4*)(ob + 16), Q1 = *(const LAS f32x4*)(ob + 20);
                const float Fx[8] = {F0.x, F0.y, F0.z, F0.w, F1.x, F1.y, F1.z, F1.w}, Kx[8] = {K0.x, K0.y, K0.z, K0.w, K1.x, K1.y, K1.z, K1.w}, Qx[8] = {Q0.x, Q0.y, Q0.z, Q0.w, Q1.x, Q1.y, Q1.z, Q1.w};
                const float v0 = cv[t * 128 + lane], v1 = cv[t * 128 + 64 + lane]; float o0 = 0.f, o1 = 0.f;
#pragma unroll
                for (int d = 0; d < 8; ++d) { S[d][0] = Fx[d] * S[d][0] + Kx[d] * v0; S[d][1] = Fx[d] * S[d][1] + Kx[d] * v1; o0 += Qx[d] * S[d][0]; o1 += Qx[d] * S[d][1]; }
                OPL[(t * 4 + wave) * 128 + lane] = o0; OPL[(t * 4 + wave) * 128 + 64 + lane] = o1; }
        }
        if (more) { LAS float* no = OPS + ((ci + 1) & 1) * 1536; LAS float* nv = VV + ((ci + 1) & 1) * 2048;
            const float fg = lb + (1.0f - lb) * sigm(pf); no[slot] = fg; no[slot + 8] = 1.0f - fg; no[slot + 16] = pq * sigm(pq);
#pragma unroll
            for (int i = 0; i < 4; ++i) nv[tid + 512 * i] = pv[i]; }
        __syncthreads();
#pragma unroll
        for (int i = 0; i < 4; ++i) { const int idx = tid + 512 * i, t = idx >> 7, v = idx & 127;
            const float s = (OPL[(t * 4 + 0) * 128 + v] + OPL[(t * 4 + 1) * 128 + v]) + (OPL[(t * 4 + 2) * 128 + v] + OPL[(t * 4 + 3) * 128 + v]);
            OP[(size_t)dq * SZ + (size_t)(mbase + ci * 16 + t) * 512 + h * 128 + v] = s; }
        __syncthreads();
    }
    if (wave < 4) {
#pragma unroll
        for (int d = 0; d < 8; ++d) { Sout[(dq * 32 + wave * 8 + d) * 128 + lane] = S[d][0]; Sout[(dq * 32 + wave * 8 + d) * 128 + 64 + lane] = S[d][1]; } }
}
__device__ __forceinline__ void hgrn_sample_wave(LAS float* buf, const GAS float* Z, const GAS float* logits, int layer, int b, int h, int vh, const GAS float* Sin, GAS float* Sout, GAS bf16* OPB, int lane) {
    const int mbase = MP + b * 4;
#pragma unroll
    for (int t = 0; t < 4; ++t)
#pragma unroll
        for (int dd = 0; dd < 2; ++dd) { const int d = lane + 64 * dd, cfull = h * 128 + d; const float lb = hgrn_lb(logits, layer, cfull);
            const float q = Z[(size_t)(mbase + t) * NCP + C_H + cfull], f = Z[(size_t)(mbase + t) * NCP + C_H + 512 + cfull], fg = lb + (1.0f - lb) * sigm(f);
            *(LAS f32x4*)(buf + (t * 128 + d) * 4) = (f32x4){fg, 1.0f - fg, q * sigm(q), 0.f}; }
    float vt[4], o[4];
#pragma unroll
    for (int t = 0; t < 4; ++t) { vt[t] = Z[(size_t)(mbase + t) * NCP + C_H + 1024 + h * 128 + vh * 64 + lane]; o[t] = 0.f; }
    LDS_WAIT();
    float Sn[8];
#pragma unroll
    for (int dd = 0; dd < 8; ++dd) Sn[dd] = __builtin_nontemporal_load(&Sin[dd * 128 + vh * 64 + lane]);
    for (int dc = 0; dc < 16; ++dc) { float S[8];
#pragma unroll
        for (int dd = 0; dd < 8; ++dd) S[dd] = Sn[dd];
        if (dc + 1 < 16) {
#pragma unroll
            for (int dd = 0; dd < 8; ++dd) Sn[dd] = __builtin_nontemporal_load(&Sin[((dc + 1) * 8 + dd) * 128 + vh * 64 + lane]); }
#pragma unroll
        for (int t = 0; t < 4; ++t)
#pragma unroll
            for (int dd = 0; dd < 8; ++dd) { const f32x4 op = *(const LAS f32x4*)(buf + (t * 128 + dc * 8 + dd) * 4); S[dd] = op.x * S[dd] + op.y * vt[t]; o[t] += op.z * S[dd]; }
#pragma unroll
        for (int dd = 0; dd < 8; ++dd) __builtin_nontemporal_store(S[dd], &Sout[(dc * 8 + dd) * 128 + vh * 64 + lane]); }
#pragma unroll
    for (int t = 0; t < 4; ++t) { const size_t oi = (size_t)(mbase + t) * 512 + h * 128 + vh * 64 + lane; const unsigned hi = pk2(o[t], 0.f) & 0xffffu; const float hf = __builtin_bit_cast(float, hi << 16);
        OPB[oi] = (bf16)hi; OPB[SZ + oi] = bf1(o[t] - hf); }
    LDS_WAIT();
}
__device__ __forceinline__ void sgu_job(LAS unsigned char* lds, const GAS float* Wh, const GAS float* sbias, const GAS float* VLN, GAS float* U, int m0, int h, int tid) {
    LAS float* WL = (LAS float*)lds;
    LAS float* VT = (LAS float*)(lds + 67584);
#pragma unroll 2
    for (int i0 = 0; i0 < 32; i0 += 16) { float tw[16], tv[16];
#pragma unroll
        for (int i = 0; i < 16; ++i) { const int idx = tid + 512 * (i0 + i), t = idx >> 7, s = idx & 127; tw[i] = Wh[idx]; tv[i] = VLN[(size_t)(m0 + t) * 512 + h * 128 + s]; }
#pragma unroll
        for (int i = 0; i < 16; ++i) { const int idx = tid + 512 * (i0 + i), t = idx >> 7, s = idx & 127; WL[t * 132 + s] = (s <= t) ? tw[i] : 0.f; VT[idx] = tv[i]; } }
    __syncthreads();
    const int t0 = (tid >> 4) * 4, d0 = (tid & 15) * 8;
    float acc[4][8];
#pragma unroll
    for (int i = 0; i < 4; ++i)
#pragma unroll
        for (int j = 0; j < 8; ++j) acc[i][j] = 0.f;
    for (int s = 0; s <= t0 + 3; ++s) {
        const f32x4 v0 = *(const LAS f32x4*)(VT + s * 128 + d0), v1 = *(const LAS f32x4*)(VT + s * 128 + d0 + 4);
#pragma unroll
        for (int i = 0; i < 4; ++i) { const float w = WL[(t0 + i) * 132 + s];
            acc[i][0] += w * v0.x; acc[i][1] += w * v0.y; acc[i][2] += w * v0.z; acc[i][3] += w * v0.w; acc[i][4] += w * v1.x; acc[i][5] += w * v1.y; acc[i][6] += w * v1.z; acc[i][7] += w * v1.w; }
    }
#pragma unroll
    for (int i = 0; i < 4; ++i) { const int t = t0 + i; const float bias = sbias[t]; GAS float* up = U + (size_t)(m0 + t) * 512 + h * 128 + d0;
        f32x4 u0 = *(const GAS f32x4*)up, u1 = *(const GAS f32x4*)(up + 4);
        u0.x *= acc[i][0] + bias; u0.y *= acc[i][1] + bias; u0.z *= acc[i][2] + bias; u0.w *= acc[i][3] + bias; u1.x *= acc[i][4] + bias; u1.y *= acc[i][5] + bias; u1.z *= acc[i][6] + bias; u1.w *= acc[i][7] + bias;
        *(GAS f32x4*)up = u0; *(GAS f32x4*)(up + 4) = u1; }
    __syncthreads();
}
typedef float f32x2 __attribute__((ext_vector_type(2)));
constexpr int RW_D = 8, RW_NS = 9;
__device__ __forceinline__ void rwkv_prompt_wave(LAS float* ring, const GAS float* RW, int mbase, int h, int rg, GAS float* Sout, GAS float* YR, int lane) {
    const int rl = lane >> 3, cgp = lane & 7;
    f32x2 S[4];
#pragma unroll
    for (int i = 0; i < 4; ++i) S[i] = (f32x2){0.f, 0.f};
    unsigned off[6];
#pragma unroll
    for (int i = 0; i < 6; ++i) { const int e = i * 256 + lane * 4, st = e / 384, rem = e - st * 384; off[i] = (unsigned)((rem >> 6) * SZ + st * 512 + (rem & 63)); }
    const GAS float* gp = RW + (size_t)mbase * 512 + h * 64;
    constexpr int NCH = SEQ / 4;
#define RW_ISSUE(cc, slot) do { const GAS float* g_ = gp + (size_t)(cc) * 2048; LAS float* l_ = ring + (slot) * 1536; _Pragma("unroll") for (int i_ = 0; i_ < 6; ++i_) \
        __builtin_amdgcn_global_load_lds((const GAS unsigned*)(g_ + off[i_]), (LAS unsigned*)(l_ + i_ * 256), 16, 0, 0); } while (0)
    for (int cc = 0; cc < RW_D - 1; ++cc) RW_ISSUE(cc, cc);
    float ykeep = 0.f;
    struct RwOps { f32x4 r0, r1, w0, w1, k0, k1, a0, a1, b0, b1; float vv; };
#define RW_LOAD(o, sb_) do { const LAS float* sb = (sb_); (o).r0 = *(const LAS f32x4*)(sb + cgp * 8); (o).r1 = *(const LAS f32x4*)(sb + cgp * 8 + 4); (o).w0 = *(const LAS f32x4*)(sb + 64 + cgp * 8); (o).w1 = *(const LAS f32x4*)(sb + 64 + cgp * 8 + 4); \
        (o).k0 = *(const LAS f32x4*)(sb + 128 + cgp * 8); (o).k1 = *(const LAS f32x4*)(sb + 128 + cgp * 8 + 4); (o).a0 = *(const LAS f32x4*)(sb + 256 + cgp * 8); (o).a1 = *(const LAS f32x4*)(sb + 256 + cgp * 8 + 4); \
        (o).b0 = *(const LAS f32x4*)(sb + 320 + cgp * 8); (o).b1 = *(const LAS f32x4*)(sb + 320 + cgp * 8 + 4); (o).vv = sb[192 + rg * 8 + rl]; asm volatile("" ::: "memory"); } while (0)
#define RW_STEP(o, s_) do { \
        const f32x2 rr[4] = {{(o).r0.x, (o).r0.y}, {(o).r0.z, (o).r0.w}, {(o).r1.x, (o).r1.y}, {(o).r1.z, (o).r1.w}}, ww[4] = {{(o).w0.x, (o).w0.y}, {(o).w0.z, (o).w0.w}, {(o).w1.x, (o).w1.y}, {(o).w1.z, (o).w1.w}}; \
        const f32x2 kx[4] = {{(o).k0.x, (o).k0.y}, {(o).k0.z, (o).k0.w}, {(o).k1.x, (o).k1.y}, {(o).k1.z, (o).k1.w}}, ax[4] = {{(o).a0.x, (o).a0.y}, {(o).a0.z, (o).a0.w}, {(o).a1.x, (o).a1.y}, {(o).a1.z, (o).a1.w}}; \
        const f32x2 bx[4] = {{(o).b0.x, (o).b0.y}, {(o).b0.z, (o).b0.w}, {(o).b1.x, (o).b1.y}, {(o).b1.z, (o).b1.w}}; \
        const f32x2 p = (S[0] * ax[0] + S[1] * ax[1]) + (S[2] * ax[2] + S[3] * ax[3]); \
        const float sa = red8(p.x + p.y); const float vv = (o).vv; \
        _Pragma("unroll") for (int i = 0; i < 4; ++i) S[i] = S[i] * ww[i] + (bx[i] * sa + kx[i] * vv); \
        const f32x2 y2 = (S[0] * rr[0] + S[1] * rr[1]) + (S[2] * rr[2] + S[3] * rr[3]); \
        const float y = red8(y2.x + y2.y); if (cgp == (s_)) ykeep = y; } while (0)
    RwOps oA, oB, oC, oD;
    asm volatile("s_waitcnt vmcnt(36)" ::: "memory");
    RW_LOAD(oA, ring); RW_LOAD(oB, ring + 384);
    for (int ci = 0; ci < NCH; ++ci) {
        { const int cn = ci + RW_D - 1; const int cl = cn < NCH ? cn : NCH - 1; RW_ISSUE(cl, cn % RW_NS); }
        const LAS float* cb = ring + (ci % RW_NS) * 1536; const LAS float* nb = ring + ((ci + 1) % RW_NS) * 1536;
        RW_LOAD(oC, cb + 768);  RW_STEP(oA, 0);
        RW_LOAD(oD, cb + 1152); RW_STEP(oB, 1);
        asm volatile("s_waitcnt vmcnt(36)" ::: "memory");
        RW_LOAD(oA, nb);        RW_STEP(oC, 2);
        RW_LOAD(oB, nb + 384);  RW_STEP(oD, 3);
        if (cgp < 4) YR[(size_t)(mbase + ci * 4 + cgp) * 512 + h * 64 + rg * 8 + rl] = ykeep;
    }
#undef RW_LOAD
#undef RW_STEP
    asm volatile("s_waitcnt vmcnt(0)" ::: "memory");
#undef RW_ISSUE
    GAS float* so = Sout + (rg * 8 + rl) * 64 + cgp * 8;
    *(GAS f32x4*)so = (f32x4){S[0].x, S[0].y, S[1].x, S[1].y}; *(GAS f32x4*)(so + 4) = (f32x4){S[2].x, S[2].y, S[3].x, S[3].y};
}
constexpr int R4_NS = 5;
__device__ __forceinline__ void rwkv_prompt_wave4(LAS float* ring, const GAS float* RW, int mbase, int h, int rq, GAS float* Sout, GAS float* YR, int lane) {
    const int rl = lane >> 4, cgp = lane & 15;
    f32x2 S[2] = {{0.f, 0.f}, {0.f, 0.f}};
    unsigned off[6];
#pragma unroll
    for (int i = 0; i < 6; ++i) { const int e = i * 256 + lane * 4, st = e / 384, rem = e - st * 384; off[i] = (unsigned)((rem >> 6) * SZ + st * 512 + (rem & 63)); }
    const GAS float* gp = RW + (size_t)mbase * 512 + h * 64;
    constexpr int NCH = SEQ / 4;
#define R4_ISSUE(cc, slot) do { const GAS float* g_ = gp + (size_t)(cc) * 2048; LAS float* l_ = ring + (slot) * 1536; _Pragma("unroll") for (int i_ = 0; i_ < 6; ++i_) \
        __builtin_amdgcn_global_load_lds((const GAS unsigned*)(g_ + off[i_]), (LAS unsigned*)(l_ + i_ * 256), 16, 0, 0); } while (0)
    struct R4Ops { f32x4 r, w, k, a, b; float vv; };
#define R4_LOAD(o, sb_) do { const LAS float* sb = (sb_); (o).r = *(const LAS f32x4*)(sb + cgp * 4); (o).w = *(const LAS f32x4*)(sb + 64 + cgp * 4); (o).k = *(const LAS f32x4*)(sb + 128 + cgp * 4); \
        (o).a = *(const LAS f32x4*)(sb + 256 + cgp * 4); (o).b = *(const LAS f32x4*)(sb + 320 + cgp * 4); (o).vv = sb[192 + rq * 4 + rl]; asm volatile("" ::: "memory"); } while (0)
#define R4_STEP(o, s_) do { \
        const f32x2 a0 = {(o).a.x, (o).a.y}, a1 = {(o).a.z, (o).a.w}, w0 = {(o).w.x, (o).w.y}, w1 = {(o).w.z, (o).w.w}, k0 = {(o).k.x, (o).k.y}, k1 = {(o).k.z, (o).k.w}; \
        const f32x2 b0 = {(o).b.x, (o).b.y}, b1 = {(o).b.z, (o).b.w}, r0 = {(o).r.x, (o).r.y}, r1 = {(o).r.z, (o).r.w}; \
        const f32x2 p = S[0] * a0 + S[1] * a1; const float sa = red16(p.x + p.y); const float vv = (o).vv; \
        S[0] = S[0] * w0 + (b0 * sa + k0 * vv); S[1] = S[1] * w1 + (b1 * sa + k1 * vv); \
        const f32x2 y2 = S[0] * r0 + S[1] * r1; const float y = red16(y2.x + y2.y); if (cgp == (s_)) ykeep = y; } while (0)
    for (int cc = 0; cc < 3; ++cc) R4_ISSUE(cc, cc);
    float ykeep = 0.f;
    R4Ops oA, oB, oC, oD;
    asm volatile("s_waitcnt vmcnt(12)" ::: "memory");
    R4_LOAD(oA, ring); R4_LOAD(oB, ring + 384);
    for (int ci = 0; ci < NCH; ++ci) {
        { const int cn = ci + 3; const int cl = cn < NCH ? cn : NCH - 1; R4_ISSUE(cl, cn % R4_NS); }
        const LAS float* cb = ring + (ci % R4_NS) * 1536; const LAS float* nb = ring + ((ci + 1) % R4_NS) * 1536;
        R4_LOAD(oC, cb + 768);  R4_STEP(oA, 0);
        R4_LOAD(oD, cb + 1152); R4_STEP(oB, 1);
        asm volatile("s_waitcnt vmcnt(12)" ::: "memory");
        R4_LOAD(oA, nb);        R4_STEP(oC, 2);
        R4_LOAD(oB, nb + 384);  R4_STEP(oD, 3);
        if (cgp < 4) YR[(size_t)(mbase + ci * 4 + cgp) * 512 + h * 64 + rq * 4 + rl] = ykeep;
    }
    asm volatile("s_waitcnt vmcnt(0)" ::: "memory");
#undef R4_ISSUE
#undef R4_LOAD
#undef R4_STEP
    *(GAS f32x4*)(Sout + (rq * 4 + rl) * 64 + cgp * 4) = (f32x4){S[0].x, S[0].y, S[1].x, S[1].y};
}
__device__ __forceinline__ void hgrn_prompt_job3(LAS unsigned char* lds, const GAS float* Z, const GAS float* logits, int layer, int b, int h, int de, GAS bf16* OPB, GAS float* Sout, int tid, int lane, int wave) {
    LAS float* OPS = (LAS float*)lds;
    LAS float* VV = (LAS float*)(lds + 12288);
    LAS float* OPL = (LAS float*)(lds + 28672);
    const bool helper = wave >= 4; const int ht = tid & 255;
    const int sd = ht & 15, st = ht >> 4, cfull = h * 128 + de * 16 + sd;
    const float lb = hgrn_lb(logits, layer, cfull);
    const int mbase = b * SEQ;
    const GAS float* zq = Z + (size_t)mbase * NCP + C_H + cfull; const GAS float* zf = zq + 512; const GAS float* zv = Z + (size_t)mbase * NCP + C_H + 1024 + h * 128;
    const int slot = (st * 4 + (sd >> 2)) * 12 + (sd & 3);
    GAS bf16* opo = OPB + (size_t)de * SZ + (size_t)mbase * 512 + h * 128;
    if (helper) {
        { const float f = zf[(size_t)st * NCP], q = zq[(size_t)st * NCP], fg = lb + (1.0f - lb) * sigm(f); OPS[slot] = fg; OPS[slot + 4] = 1.0f - fg; OPS[slot + 8] = q * sigm(q); }
#pragma unroll
        for (int i = 0; i < 8; ++i) { const int idx = ht + 256 * i; VV[idx] = zv[(size_t)(idx >> 7) * NCP + (idx & 127)]; } }
    __syncthreads();
    f32x2 S[4];
#pragma unroll
    for (int d = 0; d < 4; ++d) S[d] = (f32x2){0.f, 0.f};
    constexpr int NCH = SEQ / 16;
#define HG_REDUCE(cprev) do { const LAS float* ol = OPL + ((cprev) & 1) * 8192; _Pragma("unroll") for (int i = 0; i < 4; ++i) { const int idx = ht + 256 * i, t = idx >> 6, v = (idx & 63) * 2; \
        const f32x2 a0 = *(const LAS f32x2*)(ol + (t * 4 + 0) * 128 + v), a1 = *(const LAS f32x2*)(ol + (t * 4 + 1) * 128 + v), a2 = *(const LAS f32x2*)(ol + (t * 4 + 2) * 128 + v), a3 = *(const LAS f32x2*)(ol + (t * 4 + 3) * 128 + v); \
        const f32x2 sm = (a0 + a1) + (a2 + a3); *(GAS unsigned*)(opo + (size_t)((cprev) * 16 + t) * 512 + v) = pk2(sm.x, sm.y); } } while (0)
    float pf = 0.f, pq = 0.f, pv[8];
    if (helper) { pf = zf[(size_t)(16 + st) * NCP]; pq = zq[(size_t)(16 + st) * NCP];
#pragma unroll
        for (int i = 0; i < 8; ++i) { const int idx = ht + 256 * i; pv[i] = zv[(size_t)(16 + (idx >> 7)) * NCP + (idx & 127)]; } }
    for (int ci = 0; ci < NCH; ++ci) {
        if (helper) {
            if (ci + 1 < NCH) { LAS float* no = OPS + ((ci + 1) & 1) * 768; LAS float* nv = VV + ((ci + 1) & 1) * 2048;
                const float fg = lb + (1.0f - lb) * sigm(pf); no[slot] = fg; no[slot + 4] = 1.0f - fg; no[slot + 8] = pq * sigm(pq);
#pragma unroll
                for (int i = 0; i < 8; ++i) nv[ht + 256 * i] = pv[i]; }
            if (ci + 2 < NCH) { const size_t row = (size_t)(ci + 2) * 16; pf = zf[(row + st) * NCP]; pq = zq[(row + st) * NCP];
#pragma unroll
                for (int i = 0; i < 8; ++i) { const int idx = ht + 256 * i; pv[i] = zv[(row + (idx >> 7)) * NCP + (idx & 127)]; } }
            if (ci > 0) HG_REDUCE(ci - 1);
        } else {
            const LAS float* co = OPS + (ci & 1) * 768; const LAS float* cv = VV + (ci & 1) * 2048; LAS float* ol = OPL + (ci & 1) * 8192;
            struct HgOps { f32x4 F, K, Q; float v0, v1; };
#define HG_LOAD(o, t_) do { const LAS float* ob = co + ((t_) * 4 + wave) * 12; (o).F = *(const LAS f32x4*)ob; (o).K = *(const LAS f32x4*)(ob + 4); (o).Q = *(const LAS f32x4*)(ob + 8); \
        (o).v0 = cv[(t_) * 128 + lane]; (o).v1 = cv[(t_) * 128 + 64 + lane]; asm volatile("" ::: "memory"); } while (0)
#define HG_STEP(o, t_) do { const f32x2 v2 = {(o).v0, (o).v1}; \
        S[0] = S[0] * (o).F.x + v2 * (o).K.x; S[1] = S[1] * (o).F.y + v2 * (o).K.y; S[2] = S[2] * (o).F.z + v2 * (o).K.z; S[3] = S[3] * (o).F.w + v2 * (o).K.w; \
        const f32x2 oa = (S[0] * (o).Q.x + S[1] * (o).Q.y) + (S[2] * (o).Q.z + S[3] * (o).Q.w); ol[((t_) * 4 + wave) * 128 + lane] = oa.x; ol[((t_) * 4 + wave) * 128 + 64 + lane] = oa.y; } while (0)
            HgOps hA, hB;
            HG_LOAD(hA, 0);
#pragma unroll 2
            for (int t = 0; t < 16; t += 2) { HG_LOAD(hB, t + 1); HG_STEP(hA, t); if (t + 2 < 16) HG_LOAD(hA, t + 2); HG_STEP(hB, t + 1); }
#undef HG_LOAD
#undef HG_STEP
        }
        __syncthreads();
    }
    if (helper) HG_REDUCE(NCH - 1);
    else {
#pragma unroll
        for (int d = 0; d < 4; ++d) { Sout[(de * 16 + wave * 4 + d) * 128 + lane] = S[d].x; Sout[(de * 16 + wave * 4 + d) * 128 + 64 + lane] = S[d].y; } }
#undef HG_REDUCE
    __syncthreads();
}
__device__ __forceinline__ void m2_phase(ArgP A, int layer, LAS unsigned char* lds, int tid, int lane, int wave, int bid, int G) {
    const GAS float* Z = (const GAS float*)(A->ws + WS_A);
    const GAS float* RW = (const GAS float*)(A->ws + WS_B);
    GAS float* YR = (GAS float*)(A->ws + WS_C); GAS float* U = YR + SZ; const GAS float* VLN = U + SZ; GAS bf16* OPB = (GAS bf16*)(YR + 3 * SZ);
    const GAS float* logits = A->in[29];
    if (bid >= (G >> 1)) for (int job = bid - (G >> 1); job < 256; job += G - (G >> 1)) { const int b = job >> 6, n = (job >> 2) & 15, h = job & 3;
        sgu_job(lds, A->in[26] + ((size_t)layer * 4 + h) * 128 * 128, A->in[27] + (layer * 4 + h) * 128, VLN, U, b * SEQ + n * 128, h, tid); }
    LAS float* wbuf = (LAS float*)(lds + wave * 12288);
    for (int gw = bid * NWAVES + wave; gw < 2048; gw += G * NWAVES) {
        if (gw < 1024) { const int b = gw >> 3, h = gw & 7; const size_t so = (((size_t)layer * 128 + b) * 8 + h) * 4096;
            rwkv_sample_wave(wbuf, RW, MP + b * 4, h, A->in[2] + so, A->out + O_WKV_S + so, YR, lane); }
        else { const int j = gw - 1024, b = j >> 3, h = (j >> 1) & 3, vh = j & 1; const size_t so = (((size_t)layer * 128 + b) * 4 + h) * 16384;
            hgrn_sample_wave(wbuf, Z, logits, layer, b, h, vh, A->in[4] + so, A->out + O_HG_S + so, OPB, lane); }
    }
    __syncthreads();
    const int Gh = G >> 1;
    for (int rep_ = 0; rep_ < REP_M2; ++rep_) {
    if (bid < Gh) {
        if (wave < 4) for (int rr_ = 0; rr_ < REP_RWKV; ++rr_) for (int job = bid * 4 + wave; job < 512; job += Gh * 4) { const int b = job >> 7, h = (job >> 4) & 7, rq = job & 15;
            rwkv_prompt_wave4((LAS float*)(lds + wave * 30720), RW, b * SEQ, h, rq, A->out + O_WKV_P + (((size_t)layer * 4 + b) * 8 + h) * 4096, YR, lane); }
    } else {
        for (int rh_ = 0; rh_ < REP_HGRN; ++rh_) for (int job = bid - Gh; job < 128; job += G - Gh) { const int b = job >> 5, h = (job >> 3) & 3, de = job & 7;
            hgrn_prompt_job3(lds, Z, logits, layer, b, h, de, OPB, A->out + O_HG_P + (((size_t)layer * 4 + b) * 4 + h) * 16384, tid, lane, wave); }
    }
    }
}

template <int T> __device__ __forceinline__ void pool_window(const float (&hv)[15], const float (&zv)[T], int win, float inv_full, bool zero_hist, int tq0, LAS float* DT, int trow0, int j) {
    float P[16 + T]; P[0] = 0.f;
#pragma unroll
    for (int i = 0; i < 15; ++i) P[i + 1] = P[i] + hv[i];
#pragma unroll
    for (int t = 0; t < T; ++t) P[16 + t] = P[15 + t] + zv[t];
#pragma unroll
    for (int t = 0; t < T; ++t) { float lo = P[14 + t];
        if (win == 4) lo = P[12 + t]; else if (win == 8) lo = P[8 + t]; else if (win == 16) lo = P[t];
        float inv = inv_full; if (zero_hist) { const int n = tq0 + t + 1; inv = (n < win) ? 1.0f / (float)n : inv_full; }
        DT[(trow0 + t) * 512 + j] = (P[16 + t] - lo) * inv - zv[t]; }
}
__device__ __forceinline__ void m3_phase(ArgP A, int layer, LAS unsigned char* lds, int tid, int lane, int wave, int bid, int G) {
    const GAS float* Z = (const GAS float*)(A->ws + WS_A);
    const GAS float* RW = (const GAS float*)(A->ws + WS_B); const GAS float* RK = RW + 7 * SZ;
    const GAS float* YR = (const GAS float*)(A->ws + WS_C); const GAS float* U = YR + SZ; const GAS float* VLN = U + SZ; const GAS bf16* OPB = (const GAS bf16*)(YR + 3 * SZ);
    GAS bf16* YC = (GAS bf16*)(A->ws + WS_XN);
    const GAS float* gnw = A->in[22] + layer * 512; const GAS float* gnb = A->in[23] + layer * 512; const GAS float* sguw = A->in[26] + (size_t)layer * 4 * 128 * 128; const GAS float* sgub = A->in[27] + layer * 512;
    const GAS float* sgun = A->in[28] + layer * 512; const GAS float* hgn = A->in[30] + layer * 512; const GAS float* pw = A->in[31] + (size_t)layer * 4 * 128 * 128; const GAS float* psc = A->in[32] + layer * 512;
    const GAS float* pst = A->in[5] + (size_t)layer * 128 * 15 * 512;
    LAS float* P1 = (LAS float*)lds; LAS float* P2 = P1 + 128; LAS float* DT = (LAS float*)(lds + 1024);
    const int j = tid, wv = wave, hh = j >> 7, c = lane & 15, quad = lane >> 4, g = wv >> 1, colbase = (wv & 1) * 64;
    const int win = 2 << hh; const float inv_full = 1.0f / (float)win;
    const float gnw_j = gnw[j], gnb_j = gnb[j];
    bf16x8 bp[4][4];
#pragma unroll
    for (int ct = 0; ct < 4; ++ct)
#pragma unroll
        for (int kk = 0; kk < 4; ++kk) { float tb[8];
#pragma unroll
            for (int jj = 0; jj < 8; ++jj) tb[jj] = pw[(size_t)(g * 128 + kk * 32 + quad * 8 + jj) * 128 + colbase + ct * 16 + c];
            bp[kk][ct] = pack8(tb); }
    for (int tile = bid; tile < MT / 16; tile += G) {
        const int m0 = tile * 16;
        float us_t[16], o_t[16];
        if (m0 < MP) {
#pragma unroll
            for (int tg = 0; tg < 16; tg += 8) {
                float y4[8], u4[8], rk4[8], rv4[8], rg4[8]; unsigned q4[8][8];
#pragma unroll
                for (int i = 0; i < 8; ++i) { const int m = m0 + tg + i; const size_t mo = (size_t)m * 512 + j;
                    y4[i] = __builtin_nontemporal_load(&YR[mo]); u4[i] = __builtin_nontemporal_load(&U[mo]); rk4[i] = RK[m * 8 + wv]; rv4[i] = __builtin_nontemporal_load(&RW[3 * SZ + mo]); rg4[i] = __builtin_nontemporal_load(&RW[6 * SZ + mo]);
#pragma unroll
                    for (int pp = 0; pp < 8; ++pp) q4[i][pp] = __builtin_nontemporal_load(&OPB[(size_t)pp * SZ + mo]); }
#pragma unroll
                for (int i = 0; i < 8; ++i) { const int t = tg + i, m = m0 + t; const float y = y4[i], u = u4[i];
                    const float o = ((__builtin_bit_cast(float, q4[i][0] << 16) + __builtin_bit_cast(float, q4[i][1] << 16)) + (__builtin_bit_cast(float, q4[i][2] << 16) + __builtin_bit_cast(float, q4[i][3] << 16)))
                                  + ((__builtin_bit_cast(float, q4[i][4] << 16) + __builtin_bit_cast(float, q4[i][5] << 16)) + (__builtin_bit_cast(float, q4[i][6] << 16) + __builtin_bit_cast(float, q4[i][7] << 16)));
                    us_t[t] = u; o_t[t] = o;
                    const float r0 = wave_sum(y), r1 = wave_sum(y * y), r2 = wave_sum(u * u), r3 = wave_sum(o * o);
                    const float mean = r0 * (1.0f / 64.0f), var = fmaxf(r1 * (1.0f / 64.0f) - mean * mean, 0.f);
                    const float yn = (y - mean) * rsqrtf(var + 64e-5f) * gnw_j + gnb_j;
                    YC[(size_t)m * DM + j] = bf1((yn + rk4[i] * rv4[i]) * rg4[i]);
                    if (lane == 0) { P1[t * 8 + wv] = r2; P2[t * 8 + wv] = r3; } }
            }
        } else {
#pragma unroll
            for (int sq = 0; sq < 4; ++sq) {
                float y4[4], u4[4], vl4[4], rk4[4], rv4[4], rg4[4], bb4[4], w4[4][4]; unsigned qa[4], qb[4];
#pragma unroll
                for (int i = 0; i < 4; ++i) { const int m = m0 + sq * 4 + i; const size_t mo = (size_t)m * 512 + j;
                    y4[i] = YR[mo]; u4[i] = U[mo]; vl4[i] = VLN[mo]; rk4[i] = RK[m * 8 + wv]; rv4[i] = RW[3 * SZ + mo]; rg4[i] = RW[6 * SZ + mo]; qa[i] = OPB[mo]; qb[i] = OPB[SZ + mo]; bb4[i] = sgub[hh * 128 + i];
#pragma unroll
                    for (int sp = 0; sp < 4; ++sp) w4[i][sp] = (sp <= i) ? sguw[(hh * 128 + i) * 128 + sp] : 0.f; }
#pragma unroll
                for (int i = 0; i < 4; ++i) { const int t = sq * 4 + i, m = m0 + t; const float y = y4[i];
                    const float sacc = bb4[i] + ((w4[i][0] * vl4[0] + w4[i][1] * vl4[1]) + (w4[i][2] * vl4[2] + w4[i][3] * vl4[3]));
                    const float u = u4[i] * sacc; const float o = __builtin_bit_cast(float, qa[i] << 16) + __builtin_bit_cast(float, qb[i] << 16);
                    us_t[t] = u; o_t[t] = o;
                    const float r0 = wave_sum(y), r1 = wave_sum(y * y), r2 = wave_sum(u * u), r3 = wave_sum(o * o);
                    const float mean = r0 * (1.0f / 64.0f), var = fmaxf(r1 * (1.0f / 64.0f) - mean * mean, 0.f);
                    const float yn = (y - mean) * rsqrtf(var + 64e-5f) * gnw_j + gnb_j;
                    YC[(size_t)m * DM + j] = bf1((yn + rk4[i] * rv4[i]) * rg4[i]);
                    if (lane == 0) { P1[t * 8 + wv] = r2; P2[t * 8 + wv] = r3; } }
            }
        }
        if (m0 < MP) {
            const int tq0 = m0 & (SEQ - 1); const bool zh = (tq0 == 0); float hv[15], zv[16];
#pragma unroll
            for (int i = 0; i < 15; ++i) hv[i] = zh ? 0.f : Z[(size_t)(m0 - 15 + i) * NCP + C_P + j];
#pragma unroll
            for (int t = 0; t < 16; ++t) zv[t] = Z[(size_t)(m0 + t) * NCP + C_P + j];
            pool_window<16>(hv, zv, win, inv_full, zh, tq0, DT, 0, j);
            if (tq0 == SEQ - 16) {
#pragma unroll
                for (int i = 0; i < 15; ++i) A->out[O_PL_P + (((size_t)layer * 4 + (m0 >> 11)) * 15 + i) * 512 + j] = zv[i + 1]; }
        } else {
#pragma unroll
            for (int sq = 0; sq < 4; ++sq) { const int bq = ((m0 - MP) >> 2) + sq; float hv[15], zv[4];
#pragma unroll
                for (int i = 0; i < 15; ++i) hv[i] = pst[((size_t)bq * 15 + i) * 512 + j];
#pragma unroll
                for (int t = 0; t < 4; ++t) zv[t] = Z[(size_t)(m0 + sq * 4 + t) * NCP + C_P + j];
                pool_window<4>(hv, zv, win, inv_full, false, 0, DT, sq * 4, j);
#pragma unroll
                for (int i = 0; i < 15; ++i) A->out[O_PL_S + (((size_t)layer * 128 + bq) * 15 + i) * 512 + j] = (i < 11) ? hv[i + 4] : zv[i - 11]; }
        }
        __syncthreads();
        float gz16[16];
#pragma unroll
        for (int t = 0; t < 16; ++t) gz16[t] = Z[(size_t)(m0 + t) * NCP + C_H + 1536 + j];
#pragma unroll
        for (int t = 0; t < 16; ++t) { const int m = m0 + t;
            float s1 = 0.f;
#pragma unroll
            for (int w = 0; w < 8; ++w) s1 += P1[t * 8 + w];
            YC[(size_t)m * DM + 512 + j] = bf1(us_t[t] * rsqrtf(s1 * (1.0f / 512.0f) + 1e-6f) * sgun[j]);
            const float s2 = P2[t * 8 + (wv & ~1)] + P2[t * 8 + (wv | 1)]; const float gz = gz16[t];
            YC[(size_t)m * DM + 1024 + j] = bf1(o_t[t] * rsqrtf(s2 * (1.0f / 128.0f) + 1e-6f) * hgn[j] * gz * sigm(gz)); }
        {
            bf16x8 ap[4];
#pragma unroll
            for (int kk = 0; kk < 4; ++kk) { const LAS float* dp = DT + c * 512 + g * 128 + kk * 32 + quad * 8; const f32x4 d0 = *(const LAS f32x4*)dp, d1 = *(const LAS f32x4*)(dp + 4);
                const float t[8] = {d0.x, d0.y, d0.z, d0.w, d1.x, d1.y, d1.z, d1.w}; ap[kk] = pack8(t); }
#pragma unroll
            for (int ct = 0; ct < 4; ++ct) { f32x4 acc = {0.f, 0.f, 0.f, 0.f}; const int cl = colbase + ct * 16 + c;
#pragma unroll
                for (int kk = 0; kk < 4; ++kk) acc = __builtin_amdgcn_mfma_f32_16x16x32_bf16(ap[kk], bp[kk][ct], acc, 0, 0, 0);
                const int col = g * 128 + cl; const float sc = psc[col];
#pragma unroll
                for (int jj = 0; jj < 4; ++jj) YC[(size_t)(m0 + quad * 4 + jj) * DM + 1536 + col] = bf1(acc[jj] * sc); }
        }
        __syncthreads();
    }
}
#ifndef REP_GEMM
#define REP_GEMM 1
#endif
#ifndef REP_M1
#define REP_M1 1
#endif
#ifndef REP_M2
#define REP_M2 1
#endif
#ifndef REP_M3
#define REP_M3 1
#endif
#ifndef REP_P0
#define REP_P0 1
#endif
#ifndef REP_ROW
#define REP_ROW 1
#endif
#ifndef MK_MULTI
#define MK_MULTI 0
#endif
__global__ void __launch_bounds__(NTHR, 2) mega_fwd(Args A_unused) {
    extern __shared__ __attribute__((aligned(16))) unsigned char lds_[];
    cg::grid_group grid = cg::this_grid();
    LAS unsigned char* lds = (LAS unsigned char*)lds_;
    const int bid = blockIdx.x, G = gridDim.x;
    volatile LAS unsigned* xst = (volatile LAS unsigned*)(lds + LDS_BYTES - 64);
    if (threadIdx.x < 16) xst[threadIdx.x] = 0u;
    __syncthreads();
    XcdBarrier xbar; { ArgP A = largs(); xbar = xcd_barrier_post((unsigned*)(A->ws + WS_CTL), xst); }
#define TL const int tid = ltid(), lane = tid & 63, wave = __builtin_amdgcn_readfirstlane(tid >> 6); (void)tid; (void)lane; (void)wave;
    int lo, hi; { ArgP A = largs(); lo = A->ph_lo; hi = A->ph_hi; }
#define GEMM_PRE ArgP A = largs(); GAS unsigned char* wb = A->ws + (size_t)layer * WL_BYTES; const bf16* XN = (const bf16*)(A->ws + WS_XN);
#define INP(k) (lo <= (k) && (k) < hi)
#ifndef REP_SYNC
#define REP_SYNC 1
#endif
#define SEAM(k) do { if (lo <= (k) && (k) + 1 < hi) for (int rs_ = 0; rs_ < REP_SYNC; ++rs_) { if (lo < 0) grid.sync(); else xcd_barrier(xbar); }     } while (0)
#ifndef SKIP_P0
    if (INP(0)) { TL for (int rep_ = 0; rep_ < REP_P0; ++rep_) p0_prologue(largs(), lds, tid, lane, wave, bid, G); }
#endif
    SEAM(0);
#pragma unroll
    for (int layer = 0; layer < 2; ++layer) {
        const int pb = 1 + layer * 11;
        if (layer > 0) { if (INP(pb + 0)) { TL for (int rep_ = 0; rep_ < REP_ROW; ++rep_) rowA_phase(largs(), layer, lane, wave, bid, G); } SEAM(pb + 0); }
        if (INP(pb + 1)) {
            GEMM_PRE
            pg8::Gemm g{XN, (const bf16*)(wb + WO_IN), MT, NCP, DM, DM}; pg8::StaticOrder S; S.init(MT, NCP, G, bid);
            pg8::EpiF32P E{(float*)(A->ws + WS_A), NCP};
#ifndef SKIP_G1
            for (int rep_ = 0; rep_ < REP_GEMM; ++rep_) pg8::gemm_phase<pg8::EpiF32P, pg8::StaticOrder, true, true>(lds, g, S, E);
#endif
 }
        SEAM(pb + 1);
#ifndef SKIP_M1
        if (INP(pb + 2)) { TL for (int rep_ = 0; rep_ < REP_M1; ++rep_) m1_phase(largs(), layer, lds, tid, lane, wave, bid, G); }
#endif
        SEAM(pb + 2);
#ifndef SKIP_M2
        if (INP(pb + 3)) { TL m2_phase(largs(), layer, lds, tid, lane, wave, bid, G); }
#endif
        SEAM(pb + 3);
#ifndef SKIP_M3
        if (INP(pb + 4)) { TL for (int rep_ = 0; rep_ < REP_M3; ++rep_) m3_phase(largs(), layer, lds, tid, lane, wave, bid, G); }
#endif
        SEAM(pb + 4);
        if (INP(pb + 5)) {
            GEMM_PRE
            { pg8::Gemm g{XN, (const bf16*)(wb + WO_OUT), MP, DM, DM, DM}; pg8::StaticOrder S; S.init(MP, DM, G, bid);
              pg8::EpiF32 E{(float*)(A->ws + WS_MIX), DM};
              pg8::gemm_phase<pg8::EpiF32, pg8::StaticOrder, true, true>(lds, g, S, E); }
            { pg8::Gemm g{XN, (const bf16*)(wb + WO_OUT), MT, DM, 256, DM}; pg8::TailOrder S; S.init(bid, 8, 256, 32);
              pg8::EpiF32 E{(float*)(A->ws + WS_C) + (size_t)(bid % 8) * MS * DM - (size_t)MP * DM, DM};

#ifndef SKIP_TAIL
              pg8::gemm_phase<pg8::EpiF32, pg8::TailOrder, true, true>(lds, g, S, E);
#endif
 }
            { pg8::Gemm g{(const bf16*)(A->ws + WS_PB) + (size_t)layer * MT * PLED, (const bf16*)(wb + WO_PL), MT, DM, PLED, PLED}; pg8::StaticOrder S; S.init(MT, DM, G, (bid + 128) % G);
              pg8::EpiF32 E{(float*)(A->ws + WS_PLE), DM};
#ifndef SKIP_GP
              for (int rep_ = 0; rep_ < REP_GEMM; ++rep_) pg8::gemm_phase<pg8::EpiF32, pg8::StaticOrder, true, true>(lds, g, S, E);
#endif
 } }
        SEAM(pb + 5);
        if (INP(pb + 6)) { TL for (int rep_ = 0; rep_ < REP_ROW; ++rep_) rowB_phase(largs(), layer, lane, wave, bid, G); }
        SEAM(pb + 6);
        if (INP(pb + 7)) {
            GEMM_PRE
            pg8::Gemm g{XN, (const bf16*)(wb + WO_GU), MT, 2 * DFF, DM, DM}; pg8::StaticOrder S; S.init(MT, 2 * DFF, G, bid);
            pg8::EpiSwiglu E{(bf16*)(A->ws + WS_A), DFF};
#ifndef SKIP_GU
            for (int rep_ = 0; rep_ < REP_GEMM; ++rep_) pg8::gemm_phase<pg8::EpiSwiglu, pg8::StaticOrder, true, true>(lds, g, S, E);
#endif
 }
        SEAM(pb + 7);
        if (INP(pb + 8)) {
            GEMM_PRE
            { pg8::Gemm g{(const bf16*)(A->ws + WS_A), (const bf16*)(wb + WO_DN), MP, DM, DFF, DFF}; pg8::StaticOrder S; S.init(MP, DM, G, bid);
              pg8::EpiF32 E{(float*)(A->ws + WS_MIX), DM};
              pg8::gemm_phase<pg8::EpiF32, pg8::StaticOrder, true, true>(lds, g, S, E); }
            { pg8::Gemm g{(const bf16*)(A->ws + WS_A), (const bf16*)(wb + WO_DN), MT, DM, 512, DFF}; pg8::TailOrder S; S.init(bid, 11, 512, 32);
              pg8::EpiF32 E{(float*)(A->ws + WS_C) + (size_t)(bid % 11) * MS * DM - (size_t)MP * DM, DM};

#ifndef SKIP_TAIL
              pg8::gemm_phase<pg8::EpiF32, pg8::TailOrder, true, true>(lds, g, S, E);
#endif
 } }
        SEAM(pb + 8);
        if (INP(pb + 9)) { TL rowC_phase(largs(), layer, lane, wave, bid, G); }
        SEAM(pb + 9);
        if (INP(pb + 10)) {  GEMM_PRE
            { pg8::Gemm g{XN, (const bf16*)(wb + WO_GT), MP, DM, DM, DM}; pg8::StaticOrder S; S.init(MP, DM, G, bid);
              pg8::EpiGate E{(const float*)(A->ws + WS_XF), (const float*)(A->ws + WS_PLE), (float*)(A->out + O_Y), DM};
              pg8::gemm_phase<pg8::EpiGate, pg8::StaticOrder, true, true>(lds, g, S, E); }
            { pg8::Gemm g{XN, (const bf16*)(wb + WO_GT), MT, DM, 256, DM}; pg8::TailOrder S; S.init(bid, 8, 256, 32);
              pg8::EpiF32 E{(float*)(A->ws + WS_C) + (size_t)(bid % 8) * MS * DM - (size_t)MP * DM, DM};

#ifndef SKIP_TAIL
              pg8::gemm_phase<pg8::EpiF32, pg8::TailOrder, true, true>(lds, g, S, E);
#endif
 } }
        SEAM(pb + 10);
    }
    if (INP(23)) { TL final_phase(largs(), lane, wave, bid, G); }
#undef INP
#undef SEAM
}

extern "C" void kernel_launch(void* const* d_in, const int* in_sizes, int n_in, void* d_out, int out_size, void* d_ws, size_t ws_size, hipStream_t stream) {
    static int grid = 0;
    if (grid == 0) {
        if (n_in != 38 || out_size != 46777600 || ws_size < WS_END) { fprintf(stderr, "kernel_launch: unexpected shapes (n_in %d, out %d, ws %zu < %zu); nothing launched\n", n_in, out_size, ws_size, (size_t)WS_END); grid = -1; return; }
        int dev = 0, cus = 0, per_cu = 0;
        (void)hipGetDevice(&dev); (void)hipDeviceGetAttribute(&cus, hipDeviceAttributeMultiprocessorCount, dev);
        if (hipFuncSetAttribute((const void*)mega_fwd, hipFuncAttributeMaxDynamicSharedMemorySize, LDS_BYTES) != hipSuccess) { fprintf(stderr, "kernel_launch: hipFuncSetAttribute failed\n"); grid = -1; return; }
        if (hipOccupancyMaxActiveBlocksPerMultiprocessor(&per_cu, (const void*)mega_fwd, NTHR, LDS_BYTES) != hipSuccess || per_cu < 1) { fprintf(stderr, "kernel_launch: occupancy query says %d workgroups per CU\n", per_cu); per_cu = 1; }
        (void)hipGetLastError();
        grid = cus * 1;
        if (grid < 2) grid = 2;
    }
    if (grid < 0) return;
    if (hipMemsetAsync((char*)d_ws + WS_CTL, 0, CTL_BYTES, stream) != hipSuccess) { fprintf(stderr, "kernel_launch: memset of the barrier words failed\n"); return; }
    Args a{};
    for (int i = 0; i < 38; ++i) a.in[i] = (const float*)d_in[i];
    a.out = (float*)d_out; a.ws = (unsigned char*)d_ws;
#if MK_MULTI
    for (int ph = 0; ph < NPH; ++ph) { if (ph == 1) continue; a.ph_lo = ph; a.ph_hi = ph + 1; void* args[] = {&a};
        hipError_t e = hipLaunchCooperativeKernel((const void*)mega_fwd, dim3(grid), dim3(NTHR), args, LDS_BYTES, stream);
        if (e != hipSuccess) { fprintf(stderr, "kernel_launch: launch of phase %d failed: %s\n", ph, hipGetErrorString(e)); break; } }
#else
    a.ph_lo = 0; a.ph_hi = NPH; void* args[] = {&a};
    hipError_t e = hipLaunchCooperativeKernel((const void*)mega_fwd, dim3(grid), dim3(NTHR), args, LDS_BYTES, stream);
    if (e != hipSuccess) fprintf(stderr, "kernel_launch: cooperative launch failed: %s (grid %d)\n", hipGetErrorString(e), grid);
#endif
}
```
